# Optimizing an MI355X kernel written in HIP

```python
import math
import jax, jax.numpy as jnp
from jax import lax
import numpy as np

D_MODEL = 2048
BATCH = 8
SEQ = 2048
DEPTH = 2

N_MIXERS = 2
NORM_EPS = 1e-6
HGRN_HEADS = 16
HGRN_KEY_DIM = D_MODEL // HGRN_HEADS
HGRN_VAL_DIM = D_MODEL // HGRN_HEADS
HGRN_CHUNK = 16
DIFF_HEADS = 8
DIFF_HEAD_DIM = D_MODEL // (2 * DIFF_HEADS)
ROPE_THETA = 10000.0
Q_BLOCK = 128
N_GROUPS = 8
EXPERTS_PER_GROUP = 8
N_EXPERTS = N_GROUPS * EXPERTS_PER_GROUP
TOP_K = 2
EXPERT_FF = D_MODEL // 4
EXPERT_BLOCK = 128

kernel_name = 'hgrn2_diffattn_hier_moe_trunk'


def rms_norm(x, gain):
    xf = x.astype(jnp.float32)
    y = xf * lax.rsqrt(jnp.mean(xf * xf, axis=-1, keepdims=True) + NORM_EPS)
    return (y * gain.astype(jnp.float32)).astype(x.dtype)


def rope(x, positions):
    half = x.shape[-1] // 2
    inv_freq = ROPE_THETA ** (-jnp.arange(half, dtype=jnp.float32) / half)
    ang = positions.astype(jnp.float32)[..., None] * inv_freq
    cos = jnp.cos(ang)[:, :, None, :].astype(x.dtype)
    sin = jnp.sin(ang)[:, :, None, :].astype(x.dtype)
    x1, x2 = x[..., :half], x[..., half:]
    return jnp.concatenate([x1 * cos - x2 * sin, x2 * cos + x1 * sin], axis=-1)


def chunked_gated_recurrence(q, k, v, log_f):
    b, s, h, dk = q.shape
    dv = v.shape[-1]
    nc = s // HGRN_CHUNK
    r = lambda t: t.reshape(b, nc, HGRN_CHUNK, h, t.shape[-1])
    q, k, v, log_f = r(q), r(k), r(v), r(log_f)
    cum = jnp.cumsum(log_f, axis=2)
    total = cum[:, :, -1]
    q_dec = q * jnp.exp(cum)
    k_inv = k * jnp.exp(-cum)
    k_end = k * jnp.exp(total[:, :, None] - cum)
    causal = jnp.tril(jnp.ones((HGRN_CHUNK, HGRN_CHUNK), jnp.float32))
    attn = jnp.einsum('bnchk,bndhk->bnhcd', q_dec, k_inv) * causal
    o_intra = jnp.einsum('bnhcd,bndhv->bnchv', attn, v)

    def step(state, inp):
        q_c, k_c, v_c, tot = inp
        o = jnp.einsum('bchk,bhkv->bchv', q_c, state)
        state = state * jnp.exp(tot)[..., None] + jnp.einsum('bchk,bchv->bhkv', k_c, v_c)
        return state, o

    xs = (jnp.moveaxis(q_dec, 1, 0), jnp.moveaxis(k_end, 1, 0),
          jnp.moveaxis(v, 1, 0), jnp.moveaxis(total, 1, 0))
    _, o_inter = lax.scan(step, jnp.zeros((b, h, dk, dv), jnp.float32), xs)
    o = o_intra + jnp.moveaxis(o_inter, 0, 1)
    return o.reshape(b, s, h, dv)


def hgrn2_mixer(h, w_in, out_gain, w_out, lower_bound):
    b, s, _ = h.shape
    proj = h @ w_in
    q, f, i, g = jnp.split(proj, 4, axis=-1)
    q = jax.nn.silu(q.astype(jnp.float32)).reshape(b, s, HGRN_HEADS, HGRN_KEY_DIM)
    lb = lower_bound.astype(jnp.float32).reshape(HGRN_HEADS, HGRN_KEY_DIM)
    forget = lb + (1.0 - lb) * jax.nn.sigmoid(f.astype(jnp.float32).reshape(b, s, HGRN_HEADS, HGRN_KEY_DIM))
    inp = i.astype(jnp.float32).reshape(b, s, HGRN_HEADS, HGRN_VAL_DIM)
    o = chunked_gated_recurrence(q, 1.0 - forget, inp, jnp.log(forget))
    gate = jax.nn.silu(g.astype(jnp.float32).reshape(b, s, HGRN_HEADS, HGRN_VAL_DIM))
    o = rms_norm(o, out_gain) * gate
    return o.reshape(b, s, -1).astype(h.dtype) @ w_out


def diff_attention(h, positions, w_in, q_gain, k_gain, lam, sub_gain, w_out, lambda_init):
    b, s, _ = h.shape
    nh, hd = DIFF_HEADS, DIFF_HEAD_DIM
    proj = h @ w_in
    q, k, v = jnp.split(proj, [2 * nh * hd, 4 * nh * hd], axis=-1)
    q = rope(rms_norm(q.reshape(b, s, 2 * nh, hd), q_gain), positions)
    k = rope(rms_norm(k.reshape(b, s, 2 * nh, hd), k_gain), positions)
    q = q.transpose(0, 2, 1, 3) * (hd ** -0.5)
    k = k.transpose(0, 2, 1, 3)
    v = v.reshape(b, s, nh, 2 * hd).transpose(0, 2, 1, 3)
    lf = lam.astype(jnp.float32)
    lam_full = jnp.exp(jnp.sum(lf[0] * lf[1])) - jnp.exp(jnp.sum(lf[2] * lf[3])) + lambda_init
    outs = []
    for blk in range(s // Q_BLOCK):
        q0, q1 = blk * Q_BLOCK, (blk + 1) * Q_BLOCK
        scores = jnp.einsum('bhqd,bhkd->bhqk', q[:, :, q0:q1], k[:, :, :q1]).astype(jnp.float32)
        causal = jnp.arange(q1)[None, :] <= jnp.arange(q0, q1)[:, None]
        scores = jnp.where(causal, scores, -jnp.inf)
        p = jax.nn.softmax(scores, axis=-1).reshape(b, nh, 2, Q_BLOCK, q1)
        weights = (p[:, :, 0] - lam_full * p[:, :, 1]).astype(v.dtype)
        outs.append(jnp.einsum('bhqk,bhkv->bhqv', weights, v[:, :, :q1]))
    o = jnp.concatenate(outs, axis=2).transpose(0, 2, 1, 3)
    o = rms_norm(o, sub_gain) * (1.0 - lambda_init)
    return o.reshape(b, s, -1) @ w_out


def grouped_expert_mlp(xt, expert, gate, w_gate, w_up, w_down):
    n, d = xt.shape
    n_assign = n * TOP_K
    flat_e = expert.reshape(-1)
    flat_tok = jnp.arange(n_assign, dtype=jnp.int32) // TOP_K
    flat_w = gate.reshape(-1)
    order = jnp.argsort(flat_e)
    se, stok, sw = flat_e[order], flat_tok[order], flat_w[order]
    counts = jnp.bincount(flat_e, length=N_EXPERTS)
    pad_counts = (counts + EXPERT_BLOCK - 1) // EXPERT_BLOCK * EXPERT_BLOCK
    pad_end = jnp.cumsum(pad_counts)
    pad_start = pad_end - pad_counts
    start = jnp.cumsum(counts) - counts
    slot = pad_start[se] + jnp.arange(n_assign) - start[se]
    n_blocks = -(-n_assign // EXPERT_BLOCK) + N_EXPERTS
    n_rows = n_blocks * EXPERT_BLOCK
    row_tok = jnp.full((n_rows,), n, jnp.int32).at[slot].set(stok)
    row_w = jnp.zeros((n_rows,), jnp.float32).at[slot].set(sw)
    block_expert = jnp.minimum(
        jnp.searchsorted(pad_end, jnp.arange(n_blocks) * EXPERT_BLOCK, side='right'), N_EXPERTS - 1)
    x_pad = jnp.concatenate([xt, jnp.zeros((1, d), xt.dtype)], axis=0)

    def one_block(args):
        tok, e = args
        xb = x_pad[tok]
        hb = jax.nn.silu(xb @ w_gate[e]) * (xb @ w_up[e])
        return hb @ w_down[e]

    yb = lax.map(one_block, (row_tok.reshape(n_blocks, EXPERT_BLOCK), block_expert))
    y = jnp.zeros((n + 1, d), xt.dtype).at[row_tok].add(
        yb.reshape(n_rows, d) * row_w[:, None].astype(xt.dtype))
    return y[:n]


def hier_moe(h, w_group, w_expert, w_gate, w_up, w_down):
    b, s, d = h.shape
    xt = h.reshape(-1, d)
    n = xt.shape[0]
    g_prob = jax.nn.softmax((xt @ w_group).astype(jnp.float32), axis=-1)
    g_top_p, g_top = lax.top_k(g_prob, 1)
    e_logits = (xt @ w_expert).astype(jnp.float32).reshape(n, N_GROUPS, EXPERTS_PER_GROUP)
    e_logits = jnp.take_along_axis(e_logits, g_top[:, :, None], axis=1)[:, 0]
    e_top_p, e_top = lax.top_k(jax.nn.softmax(e_logits, axis=-1), TOP_K)
    gate = g_top_p * e_top_p / jnp.sum(e_top_p, axis=-1, keepdims=True)
    expert = g_top * EXPERTS_PER_GROUP + e_top
    y = grouped_expert_mlp(xt, expert, gate, w_gate, w_up, w_down)
    return y.reshape(b, s, d)


def setup_inputs(seed: int = 0) -> dict:
    key = jax.random.key(seed)
    ks = jax.random.split(key, 20)
    n_a = (DEPTH + N_MIXERS - 1) // N_MIXERS
    n_b = DEPTH // N_MIXERS
    nrm = lambda k, shape, scale: jax.random.normal(k, shape, jnp.float32) * scale
    d = D_MODEL
    return {
        'x': nrm(ks[0], (BATCH, SEQ, d), 1.0),
        'positions': jnp.tile(jnp.arange(SEQ, dtype=jnp.int32)[None, :], (BATCH, 1)),
        'mix_norm': 1.0 + nrm(ks[1], (DEPTH, d), 0.02),
        'ffn_norm': 1.0 + nrm(ks[2], (DEPTH, d), 0.02),
        'hgrn_w_in': nrm(ks[3], (n_a, d, 4 * d), d ** -0.5),
        'hgrn_out_gain': 1.0 + nrm(ks[4], (n_a, HGRN_VAL_DIM), 0.02),
        'hgrn_w_out': nrm(ks[5], (n_a, d, d), d ** -0.5),
        'hgrn_lb_logits': nrm(ks[6], (DEPTH + 1, HGRN_HEADS * HGRN_KEY_DIM), 0.1),
        'diff_w_in': nrm(ks[7], (n_b, d, 6 * DIFF_HEADS * DIFF_HEAD_DIM), d ** -0.5),
        'diff_q_gain': 1.0 + nrm(ks[8], (n_b, DIFF_HEAD_DIM), 0.02),
        'diff_k_gain': 1.0 + nrm(ks[9], (n_b, DIFF_HEAD_DIM), 0.02),
        'diff_lambda': nrm(ks[10], (n_b, 4, DIFF_HEAD_DIM), 0.1),
        'diff_sub_gain': 1.0 + nrm(ks[11], (n_b, 2 * DIFF_HEAD_DIM), 0.02),
        'diff_w_out': nrm(ks[12], (n_b, 2 * DIFF_HEADS * DIFF_HEAD_DIM, d), d ** -0.5),
        'moe_w_group': nrm(ks[13], (DEPTH, d, N_GROUPS), d ** -0.5),
        'moe_w_expert': nrm(ks[14], (DEPTH, d, N_EXPERTS), d ** -0.5),
        'moe_w_gate': nrm(ks[15], (DEPTH, N_EXPERTS, d, EXPERT_FF), d ** -0.5),
        'moe_w_up': nrm(ks[16], (DEPTH, N_EXPERTS, d, EXPERT_FF), d ** -0.5),
        'moe_w_down': nrm(ks[17], (DEPTH, N_EXPERTS, EXPERT_FF, d), EXPERT_FF ** -0.5),
    }


def reference(x, positions, mix_norm, ffn_norm, hgrn_w_in, hgrn_out_gain, hgrn_w_out, hgrn_lb_logits,
              diff_w_in, diff_q_gain, diff_k_gain, diff_lambda, diff_sub_gain, diff_w_out,
              moe_w_group, moe_w_expert, moe_w_gate, moe_w_up, moe_w_down):
    lower_bounds = jnp.cumsum(jax.nn.softmax(hgrn_lb_logits.astype(jnp.float32), axis=0), axis=0)
    h = x
    for layer in range(DEPTH):
        j = layer // N_MIXERS
        hn = rms_norm(h, mix_norm[layer])
        if layer % N_MIXERS == 0:
            mixed = hgrn2_mixer(hn, hgrn_w_in[j], hgrn_out_gain[j], hgrn_w_out[j], lower_bounds[layer])
        else:
            lambda_init = 0.8 - 0.6 * math.exp(-0.3 * layer)
            mixed = diff_attention(hn, positions, diff_w_in[j], diff_q_gain[j], diff_k_gain[j],
                                   diff_lambda[j], diff_sub_gain[j], diff_w_out[j], lambda_init)
        h = h + mixed
        h = h + hier_moe(rms_norm(h, ffn_norm[layer]), moe_w_group[layer], moe_w_expert[layer],
                         moe_w_gate[layer], moe_w_up[layer], moe_w_down[layer])
    return h
```

```cpp
#include <hip/hip_runtime.h>
#include <hip/hip_bf16.h>
#include <cstdio>
#include <cstdint>

#ifndef MK_ONE_LAUNCH
#define MK_ONE_LAUNCH 1
#endif
#ifndef PROBE_STEPS
#define PROBE_STEPS 0x0
#endif

#ifndef INPROJ_MODE
#define INPROJ_MODE 2
#endif
#define INPROJ_ESZ (INPROJ_MODE ? 1 : 2)
#ifndef OUT1_I8
#define OUT1_I8 1
#endif
#ifndef ATT_FORM
#define ATT_FORM 2
#endif
#ifndef Y_FP8
#define Y_FP8 1
#endif
#ifndef FP8_OUTPROJ
#define FP8_OUTPROJ 0
#endif
#ifndef FP8_MOE
#define FP8_MOE 1
#endif
#define LAS __attribute__((address_space(3)))
#define GAS __attribute__((address_space(1)))
#define CAS __attribute__((address_space(4)))
typedef unsigned short bf16_t;
typedef short bf16x8 __attribute__((ext_vector_type(8)));
typedef _Float16 f16x8 __attribute__((ext_vector_type(8)));
typedef short s16x4 __attribute__((ext_vector_type(4)));
typedef float f32x4 __attribute__((ext_vector_type(4)));
typedef float f32x2 __attribute__((ext_vector_type(2)));
typedef float f32x16 __attribute__((ext_vector_type(16)));
typedef unsigned u32x4 __attribute__((ext_vector_type(4)));
typedef unsigned u32x2 __attribute__((ext_vector_type(2)));
typedef int i32x4 __attribute__((ext_vector_type(4)));
typedef int i32x8 __attribute__((ext_vector_type(8)));

__device__ __forceinline__ unsigned cvt_pk_bf16(float lo, float hi) { unsigned r; asm volatile("v_cvt_pk_bf16_f32 %0, %1, %2" : "=v"(r) : "v"(lo), "v"(hi)); return r; }
__device__ __forceinline__ unsigned pk4_fp8(float a, float b, float c, float d) { int r = 0; r = __builtin_amdgcn_cvt_pk_fp8_f32(a, b, r, false); r = __builtin_amdgcn_cvt_pk_fp8_f32(c, d, r, true); return (unsigned)r; }
__device__ __forceinline__ f32x4 unpk4_fp8(unsigned w) { const f32x2 a = __builtin_amdgcn_cvt_pk_f32_fp8((int)w, false), b = __builtin_amdgcn_cvt_pk_f32_fp8((int)w, true); return (f32x4){a[0], a[1], b[0], b[1]}; }
constexpr int WSH_IN = 6, WSH_OUT = 6, WSH_GU = 6, WSH_DN = 5;
__device__ __forceinline__ float bf_lo(unsigned w) { return __uint_as_float(w << 16); }
__device__ __forceinline__ float bf_hi(unsigned w) { return __uint_as_float(w & 0xffff0000u); }
__device__ __forceinline__ float bf2f(bf16_t b) { return __uint_as_float(((unsigned)b) << 16); }
__device__ __forceinline__ float fast_exp(float x) { return __builtin_amdgcn_exp2f(x * 1.4426950408889634f); }
__device__ __forceinline__ float silu_f(float x) { return x * __builtin_amdgcn_rcpf(1.0f + fast_exp(-x)); }

constexpr int NWAVES = 8, NTHR = 512;
constexpr int BATCH = 8, SEQ = 2048, D = 2048, M = BATCH * SEQ;
constexpr int HG_H = 16, HG_K = 128;
constexpr int DA_H = 8, DA_HD = 128;
constexpr int NE = 64, FF = 512, NRT = 80;
constexpr int NP0 = 4 * D, NP1 = 6 * DA_H * DA_HD;
constexpr int RMAX = 2 * M + NE * 256;
constexpr float NORM_EPS = 1e-6f;
constexpr float LAMBDA_INIT1 = 0.35550906f;

constexpr size_t MiB = 1u << 20;
constexpr size_t WS_CTL = 0, CTL_ZERO_BYTES = 160 * 1024;
constexpr size_t WS_TOKE = 1 * MiB;
constexpr size_t WS_TOKW = WS_TOKE + (size_t)M * 8;
constexpr size_t WS_TOKP = WS_TOKW + (size_t)M * 8;
constexpr size_t WS_TOKR = WS_TOKP + (size_t)M * 8;
constexpr size_t WS_RSTDT = WS_TOKR + (size_t)M * 8;
constexpr size_t WS_RSTDR = WS_RSTDT + (size_t)M * 4;
constexpr size_t WS_ROWT = WS_RSTDR + (size_t)RMAX * 4;
constexpr size_t WS_XNS = WS_ROWT + (size_t)RMAX * 4;
constexpr size_t WS_WRT = 2 * MiB;
constexpr size_t WS_ROPE = 4 * MiB;
constexpr size_t WS_WHIN = 16 * MiB;
constexpr size_t WS_WHOUT = WS_WHIN + 32 * MiB;
constexpr size_t WS_WDIN = WS_WHOUT + 8 * MiB;
constexpr size_t WS_WDOUT = WS_WDIN + 24 * MiB;
constexpr size_t WS_WGU = WS_WDOUT + 8 * MiB;
constexpr size_t WS_WDN = WS_WGU + 512 * MiB;
constexpr size_t WS_XN = WS_WDN + 256 * MiB;
constexpr size_t WS_PROJ = WS_XN + 64 * MiB;
constexpr size_t WS_MIX = WS_PROJ + 256 * MiB;
constexpr size_t WS_H1 = WS_MIX + 64 * MiB;
constexpr size_t WS_XF = WS_H1 + 128 * MiB;
constexpr size_t WS_XP = WS_XF + 64 * MiB;
constexpr size_t WS_HID = WS_XP + 192 * MiB;
constexpr size_t WS_Y = WS_HID + 48 * MiB;
constexpr size_t WS_H2 = WS_Y + 192 * MiB;
constexpr size_t WS_END = WS_H2 + 128 * MiB;
constexpr size_t WS_XB = WS_XP + 128 * MiB;
constexpr size_t WS_ATT = WS_XP;
constexpr size_t WS_LIST = WS_HID + 40 * MiB;
static_assert(WS_END <= 2048 * MiB, "d_ws map");
static_assert(WS_XNS + (size_t)M * 4 <= WS_WRT, "small tables");
constexpr int CW_TMO = 0, CW_CODE = 1;
constexpr int CW_BAR = 4096;
constexpr int CW_CMAX = 16384;   static_assert((16384 + 8192 + 2048 + 6144 + 2048) * 4 <= 160 * 1024, "control words inside the per-call memset");
constexpr int CSC_HIN = 0, CSC_HOUT = NP0, CSC_DIN = NP0 + D, CSC_DOUT = NP0 + D + NP1;
constexpr int CW_QUEUE = 12288;
constexpr int CW_CNT = 8192;

constexpr int RING_BYTES = 147456;
constexpr int LDSCTL_OFF = RING_BYTES, MISC_OFF = LDSCTL_OFF + 320;
constexpr int TAB_OFF = MISC_OFF + 128;
constexpr int LDS_BYTES = RING_BYTES + 2048;
static_assert(TAB_OFF + (72 + 192 + 64) * 4 <= LDS_BYTES, "LDS map");

namespace pg8 {
constexpr int BM = 256, BK = 64, HALF = 128, HTB = HALF * BK * 2, STAGE_BYTES = 8 * HTB, NXCD = 8, WGM = 4;
__host__ __device__ __forceinline__ int lds_byte(int r, int c) { const int st = (r >> 4) * 2 + (c >> 5), rr = r & 15, cc = c & 31, ob = rr * 64 + cc * 2; return st * 1024 + (ob ^ (((ob >> 9) & 1) << 5)); }
__host__ __device__ __forceinline__ void stage_rc(int b, int& R, int& C) { const int st = b / 1024, sb = b % 1024, swz = sb ^ (((sb >> 9) & 1) << 5); R = (st >> 1) * 16 + swz / 64; C = (st & 1) * 32 + (swz % 64) / 2; }
__host__ __device__ __forceinline__ int perm32(int rho) { const int n = rho >> 4, i = rho & 15; return 8 * (i >> 2) + 4 * n + (i & 3); }

struct Unit { int pm, pn, aux; const char* A; const char* B; };

__device__ __forceinline__ int remap_id(int L, int nwg) { const int q = nwg / NXCD, r = nwg % NXCD, xcd = L % NXCD, off = L / NXCD; return (xcd < r ? xcd * (q + 1) : r * (q + 1) + (xcd - r) * q) + off; }

struct DenseOrder {
    static constexpr bool GATHER = false; const int2* list = nullptr; const LAS int* est = nullptr; const LAS int* cntl = nullptr;
    int nM, nN, nwg, G, c; const char* A; const char* B; size_t tstep;
    __device__ void init(const void* A_, const void* Bt_, int Mr, int N, int rowbytes, int G_, int c_) { nM = Mr / BM; nN = N / BM; nwg = nM * nN; G = G_; c = c_; A = (const char*)A_; B = (const char*)Bt_; tstep = (size_t)BM * rowbytes; }
    __device__ __forceinline__ bool next(int i, Unit& u) const {
        const long L = (long)i * G + c; if (L >= nwg) return false;
        const int wgid = remap_id((int)L, nwg);
        const int nig = WGM * nN, gid = wgid / nig, fm = gid * WGM, gsz = (nM - fm) < WGM ? (nM - fm) : WGM;
        u.pm = fm + ((wgid % nig) % gsz); u.pn = (wgid % nig) / gsz; u.aux = 0;
        u.A = A + (size_t)u.pm * tstep; u.B = B + (size_t)u.pn * tstep; return true;
    }
};
template <bool GATHER_> struct GroupOrderT {
    static constexpr bool GATHER = GATHER_; const int2* list = nullptr; const LAS int* est = nullptr; const LAS int* cntl = nullptr;
    int nM, nN, nwg, G, c; const char* A; const char* B; size_t tstepA, tstepB; const LAS int* tile_e;
    __device__ void init(const void* A_, const void* Bt_, int nM_, int N, int rowbytes, int G_, int c_, const LAS int* te) { nM = nM_; nN = N / BM; nwg = nM * nN; G = G_; c = c_; A = (const char*)A_; B = (const char*)Bt_; tstepA = (size_t)BM * rowbytes; tstepB = tstepA; tile_e = te; }
    __device__ __forceinline__ bool next(int i, Unit& u) const {
        const long L = (long)i * G + c; if (L >= nwg) return false;
        const int wgid = remap_id((int)L, nwg);
        u.pm = wgid / nN; u.pn = wgid % nN; const int e = __builtin_amdgcn_readfirstlane(tile_e[u.pm]); u.aux = e;
        u.A = GATHER ? A : A + (size_t)u.pm * tstepA; u.B = B + ((size_t)e * nN + u.pn) * tstepB; return true;
    }
};
typedef GroupOrderT<false> GroupOrder;
typedef GroupOrderT<true> GatherOrder;

template <bool DEQ, bool OUT8 = false> struct EpiAct {
    static_assert(!(DEQ && OUT8), "EpiAct");
    static constexpr bool PERM = true; static __host__ __device__ __forceinline__ int brow(int R) {
        if constexpr (OUT8) { return 64 * ((R >> 5) & 3) + 16 * ((R >> 2) & 3) + 4 * ((R >> 4) & 1) + (R & 3); } else return (R & ~31) + perm32(R & 31); }
    static constexpr int BSTEP = OUT8 ? 8 : HALF;
    bf16_t* O; int ldc; unsigned silu_mask; int seg_tiles; const float* sa; const float* sb;
    __device__ __forceinline__ void operator()(const f32x4 (&acc)[2][2][4][2], const Unit& u, int wr, int wc, int fr, int fq) const {
        const int row0 = u.pm * BM + wr * 64 + fr; const int col0 = u.pn * BM + wc * 32 + 8 * fq;
        const bool act = (silu_mask >> (u.pn / seg_tiles)) & 1u;
        f32x4 cs[2][2];
        if constexpr (DEQ) {
#pragma unroll
            for (int bj = 0; bj < 2; ++bj) { cs[bj][0] = *(const f32x4*)(sb + col0 + bj * HALF); cs[bj][1] = *(const f32x4*)(sb + col0 + bj * HALF + 4); } }
        float rsv[2][4];
#pragma unroll
        for (int ai = 0; ai < 2; ++ai)
#pragma unroll
            for (int m = 0; m < 4; ++m) { rsv[ai][m] = 1.f; if constexpr (DEQ) rsv[ai][m] = sa[row0 + ai * HALF + m * 16]; }
#pragma unroll
        for (int ai = 0; ai < 2; ++ai)
#pragma unroll
            for (int m = 0; m < 4; ++m) { bf16_t* rowp = O + (size_t)(row0 + ai * HALF + m * 16) * ldc + col0;
                const float rsc = rsv[ai][m]; u32x4 w8;
#pragma unroll
                for (int bj = 0; bj < 2; ++bj) { f32x4 v0 = acc[ai][bj][m][0], v1 = acc[ai][bj][m][1];
                    if constexpr (DEQ) {
#pragma unroll
                        for (int j = 0; j < 4; ++j) { v0[j] = (float)__float_as_int(v0[j]) * rsc * cs[bj][0][j]; v1[j] = (float)__float_as_int(v1[j]) * rsc * cs[bj][1][j]; } }
                    if (act) {
#pragma unroll
                        for (int j = 0; j < 4; ++j) { v0[j] = silu_f(v0[j]); v1[j] = silu_f(v1[j]); } }
                    if constexpr (OUT8) { const unsigned a_ = pk4_fp8(v0[0], v0[1], v0[2], v0[3]), b_ = pk4_fp8(v1[0], v1[1], v1[2], v1[3]); if (bj == 0) { w8.x = a_; w8.y = b_; } else { w8.z = a_; w8.w = b_; }
                        if (bj == 1) *(u32x4*)((unsigned char*)O + (size_t)(row0 + ai * HALF + m * 16) * ldc + u.pn * BM + wc * 64 + 16 * fq) = w8; }
                    else { u32x4 w; w.x = cvt_pk_bf16(v0[0], v0[1]); w.y = cvt_pk_bf16(v0[2], v0[3]); w.z = cvt_pk_bf16(v1[0], v1[1]); w.w = cvt_pk_bf16(v1[2], v1[3]);
                        *(u32x4*)(rowp + bj * HALF) = w; } } }
    }
};
template <bool DEQ, bool RES_F32> struct EpiRes {
    static constexpr bool PERM = true; static constexpr int BSTEP = HALF; static __host__ __device__ __forceinline__ int brow(int R) { return (R & ~31) + perm32(R & 31); }
    bf16_t* C; const void* res; int ldc; const float* sa; const float* sb;
    __device__ __forceinline__ void operator()(const f32x4 (&acc)[2][2][4][2], const Unit& u, int wr, int wc, int fr, int fq) const {
        const int row0 = u.pm * BM + wr * 64 + fr, col0 = u.pn * BM + wc * 32 + 8 * fq;
        u32x4 q[4][2], w0[4][2]; f32x4 qf[4][2][2]; f32x4 cs[2][2]; float rsv[2][4];
        if constexpr (DEQ) {
#pragma unroll
            for (int bj = 0; bj < 2; ++bj) { cs[bj][0] = *(const f32x4*)(sb + col0 + bj * HALF); cs[bj][1] = *(const f32x4*)(sb + col0 + bj * HALF + 4); }
#pragma unroll
            for (int ai = 0; ai < 2; ++ai)
#pragma unroll
                for (int m = 0; m < 4; ++m) rsv[ai][m] = sa[row0 + ai * HALF + m * 16]; }
#define ER_LOAD(ai) do { _Pragma("unroll") for (int m = 0; m < 4; ++m) _Pragma("unroll") for (int bj = 0; bj < 2; ++bj) { const size_t ro_ = (size_t)(row0 + (ai) * HALF + m * 16) * ldc + col0 + bj * HALF; \
            if constexpr (RES_F32) { qf[m][bj][0] = *(const f32x4*)((const float*)res + ro_); qf[m][bj][1] = *(const f32x4*)((const float*)res + ro_ + 4); } else q[m][bj] = *(const u32x4*)((const bf16_t*)res + ro_); } } while (0)
#define ER_CALC(ai, m, bj, w_) do { f32x4 a0 = acc[ai][bj][m][0], a1 = acc[ai][bj][m][1]; f32x4 r0_, r1_; \
            if constexpr (RES_F32) { r0_ = qf[m][bj][0]; r1_ = qf[m][bj][1]; } else { const u32x4 r = q[m][bj]; r0_ = (f32x4){bf_lo(r.x), bf_hi(r.x), bf_lo(r.y), bf_hi(r.y)}; r1_ = (f32x4){bf_lo(r.z), bf_hi(r.z), bf_lo(r.w), bf_hi(r.w)}; } \
            if constexpr (DEQ) { _Pragma("unroll") for (int j = 0; j < 4; ++j) { a0[j] = (float)__float_as_int(a0[j]) * rsv[ai][m] * cs[bj][0][j]; a1[j] = (float)__float_as_int(a1[j]) * rsv[ai][m] * cs[bj][1][j]; } } \
            const f32x4 v0 = a0 + r0_, v1 = a1 + r1_; \
            w_.x = cvt_pk_bf16(v0[0], v0[1]); w_.y = cvt_pk_bf16(v0[2], v0[3]); w_.z = cvt_pk_bf16(v1[0], v1[1]); w_.w = cvt_pk_bf16(v1[2], v1[3]); } while (0)
        ER_LOAD(0);
#pragma unroll
        for (int m = 0; m < 4; ++m)
#pragma unroll
            for (int bj = 0; bj < 2; ++bj) ER_CALC(0, m, bj, w0[m][bj]);
        asm volatile("" ::: "memory");
        ER_LOAD(1);
        asm volatile("" ::: "memory");
#pragma unroll
        for (int m = 0; m < 4; ++m)
#pragma unroll
            for (int bj = 0; bj < 2; ++bj) *(u32x4*)(C + (size_t)(row0 + m * 16) * ldc + col0 + bj * HALF) = w0[m][bj];
#pragma unroll
        for (int m = 0; m < 4; ++m)
#pragma unroll
            for (int bj = 0; bj < 2; ++bj) { u32x4 w; ER_CALC(1, m, bj, w); *(u32x4*)(C + (size_t)(row0 + HALF + m * 16) * ldc + col0 + bj * HALF) = w; }
#undef ER_LOAD
#undef ER_CALC
    }
};
struct EpiQKV {
    static constexpr bool PERM = true; static constexpr int BSTEP = HALF; static __host__ __device__ __forceinline__ int brow(int R) { return ((R >> 4) & 1) * 64 + (R >> 5) * 16 + (R & 15); }
    bf16_t* O; int ldc; const float* sa; const float* sb; const float* qg; const float* kg; const float* rc; const float* rs; LAS float* X;
    __device__ __forceinline__ void operator()(const f32x4 (&acc)[2][2][4][2], const Unit& u, int wr, int wc, int fr, int fq) const {
        const int row0 = u.pm * BM + wr * 64 + fr, lrow0 = wr * 64 + fr; const int cl = 16 * wc + 4 * fq;
        const bool qk = u.pn < 16;
        f32x4 cs[2][2]; float rsv[2][4];
#pragma unroll
        for (int bj = 0; bj < 2; ++bj)
#pragma unroll
            for (int n = 0; n < 2; ++n) cs[bj][n] = *(const f32x4*)(sb + u.pn * BM + bj * HALF + 64 * n + cl);
#pragma unroll
        for (int ai = 0; ai < 2; ++ai)
#pragma unroll
            for (int m = 0; m < 4; ++m) rsv[ai][m] = sa[row0 + ai * HALF + m * 16];
#define QKV_DEQ(ai, m, bj, n) ((f32x4){(float)__float_as_int(acc[ai][bj][m][n][0]), (float)__float_as_int(acc[ai][bj][m][n][1]), (float)__float_as_int(acc[ai][bj][m][n][2]), (float)__float_as_int(acc[ai][bj][m][n][3])} * rsv[ai][m] * cs[bj][n])
        if (!qk) {
#pragma unroll
            for (int ai = 0; ai < 2; ++ai)
#pragma unroll
                for (int m = 0; m < 4; ++m) { bf16_t* rowp = O + (size_t)(row0 + ai * HALF + m * 16) * ldc + u.pn * BM + cl;
#pragma unroll
                    for (int bj = 0; bj < 2; ++bj)
#pragma unroll
                        for (int n = 0; n < 2; ++n) { const f32x4 v = QKV_DEQ(ai, m, bj, n); u32x2 w; w.x = cvt_pk_bf16(v[0], v[1]); w.y = cvt_pk_bf16(v[2], v[3]); *(u32x2*)(rowp + bj * HALF + 64 * n) = w; } }
            return; }
        const float* gn = (u.pn < 8 ? qg : kg) + cl;
        const f32x4 g0 = *(const f32x4*)gn, g1 = *(const f32x4*)(gn + 64);
        f32x4 cv[2][4], sv[2][4];
#define QKV_LDCS(ai) do { _Pragma("unroll") for (int m = 0; m < 4; ++m) { const size_t ro = (size_t)(row0 + (ai) * HALF + m * 16) * 64 + cl; cv[ai][m] = *(const f32x4*)(rc + ro); sv[ai][m] = *(const f32x4*)(rs + ro); } } while (0)
        QKV_LDCS(0); asm volatile("" ::: "memory");
#pragma unroll
        for (int ai = 0; ai < 2; ++ai)
#pragma unroll
            for (int m = 0; m < 4; ++m)
#pragma unroll
                for (int bj = 0; bj < 2; ++bj) { const f32x4 a = QKV_DEQ(ai, m, bj, 0), b = QKV_DEQ(ai, m, bj, 1);
                    float ss = (a[0] * a[0] + a[1] * a[1]) + (a[2] * a[2] + a[3] * a[3]) + (b[0] * b[0] + b[1] * b[1]) + (b[2] * b[2] + b[3] * b[3]);
                    ss += __shfl_xor(ss, 16); ss += __shfl_xor(ss, 32);
                    if (fq == 0) X[((ai * HALF + lrow0 + m * 16) * 2 + bj) * 4 + wc] = ss; }
        asm volatile("s_waitcnt lgkmcnt(0)" ::: "memory"); __builtin_amdgcn_s_barrier(); asm volatile("" ::: "memory");
        QKV_LDCS(1); asm volatile("" ::: "memory");
#undef QKV_LDCS
#pragma unroll
        for (int ai = 0; ai < 2; ++ai)
#pragma unroll
            for (int m = 0; m < 4; ++m) { bf16_t* rowp = O + (size_t)(row0 + ai * HALF + m * 16) * ldc + u.pn * BM + cl;
#pragma unroll
                for (int bj = 0; bj < 2; ++bj) { const f32x4 p = *(const LAS f32x4*)(X + ((ai * HALF + lrow0 + m * 16) * 2 + bj) * 4);
                    const float rstd = 1.0f / sqrtf(((p[0] + p[1]) + (p[2] + p[3])) * (1.f / 128.f) + NORM_EPS);
                    const f32x4 y1 = QKV_DEQ(ai, m, bj, 0) * rstd * g0, y2 = QKV_DEQ(ai, m, bj, 1) * rstd * g1;
                    const f32x4 o1 = y1 * cv[ai][m] - y2 * sv[ai][m], o2 = y2 * cv[ai][m] + y1 * sv[ai][m];
                    u32x2 w1, w2; w1.x = cvt_pk_bf16(o1[0], o1[1]); w1.y = cvt_pk_bf16(o1[2], o1[3]); w2.x = cvt_pk_bf16(o2[0], o2[1]); w2.y = cvt_pk_bf16(o2[2], o2[3]);
                    *(u32x2*)(rowp + bj * HALF) = w1; *(u32x2*)(rowp + bj * HALF + 64) = w2; } }
#undef QKV_DEQ
    }
};
struct EpiF32Res {
    static constexpr bool PERM = false; static constexpr int BSTEP = HALF; static __host__ __device__ __forceinline__ int brow(int R) { return R; }
    float* C; const float* res; int ldc;
    __device__ __forceinline__ void operator()(const f32x4 (&acc)[2][2][4][2], const Unit& u, int wr, int wc, int fr, int fq) const {
        const int row0 = u.pm * BM + wr * 64 + fr, col0 = u.pn * BM + wc * 32 + 4 * fq;
#pragma unroll
        for (int ai = 0; ai < 2; ++ai)
#pragma unroll
            for (int m = 0; m < 4; ++m) { const size_t off = (size_t)(row0 + ai * HALF + m * 16) * ldc + col0;
                f32x4 rv[2][2];
#pragma unroll
                for (int bj = 0; bj < 2; ++bj)
#pragma unroll
                    for (int n = 0; n < 2; ++n) rv[bj][n] = *(const f32x4*)(res + off + bj * HALF + n * 16);
#pragma unroll
                for (int bj = 0; bj < 2; ++bj)
#pragma unroll
                    for (int n = 0; n < 2; ++n) *(f32x4*)(C + off + bj * HALF + n * 16) = acc[ai][bj][m][n] + rv[bj][n]; }
    }
};
struct EpiSwiglu {
    static constexpr bool PERM = true; static constexpr int BSTEP = HALF; static __host__ __device__ __forceinline__ int brow(int R) { return (R & ~31) + perm32(R & 31); }
    bf16_t* H; const int2* list; const LAS int* est; const LAS int* cntl; int ldc;
    __device__ __forceinline__ void operator()(const f32x4 (&acc)[2][2][4][2], const Unit& u, int wr, int wc, int fr, int fq) const {
        const int row0 = u.pm * BM + wr * 64 + fr; const int col0 = u.pn * HALF + wc * 32 + 8 * fq;
        float rsv[2][4];
#pragma unroll
        for (int ai = 0; ai < 2; ++ai)
#pragma unroll
            for (int m = 0; m < 4; ++m) { const int lr = row0 + ai * HALF + m * 16 - est[u.aux]; rsv[ai][m] = lr < cntl[u.aux] ? __int_as_float(list[(size_t)u.aux * M + lr].y) : 0.f; }
#pragma unroll
        for (int ai = 0; ai < 2; ++ai)
#pragma unroll
            for (int m = 0; m < 4; ++m) { const int row = row0 + ai * HALF + m * 16; const float rs = rsv[ai][m];
                f32x4 h0, h1;
#pragma unroll
                for (int j = 0; j < 4; ++j) { h0[j] = silu_f(acc[ai][0][m][0][j] * rs) * (acc[ai][1][m][0][j] * rs); h1[j] = silu_f(acc[ai][0][m][1][j] * rs) * (acc[ai][1][m][1][j] * rs); }
#if FP8_MOE
                u32x2 w; w.x = pk4_fp8(h0[0], h0[1], h0[2], h0[3]); w.y = pk4_fp8(h1[0], h1[1], h1[2], h1[3]);
                *(u32x2*)((unsigned char*)H + (size_t)row * ldc + col0) = w; }
#else
                u32x4 w; w.x = cvt_pk_bf16(h0[0], h0[1]); w.y = cvt_pk_bf16(h0[2], h0[3]); w.z = cvt_pk_bf16(h1[0], h1[1]); w.w = cvt_pk_bf16(h1[2], h1[3]);
                *(u32x4*)(H + (size_t)row * ldc + col0) = w; }
#endif
    }
};

template <class Epi, class Sched, int MODE>
__device__ __forceinline__ void gemm_phase(LAS unsigned char* lds, const int RB, const Sched& S, const Epi& E, const int wsc) {
    const int tid = threadIdx.x, wid = __builtin_amdgcn_readfirstlane(tid >> 6), lane = tid & 63, wr = wid >> 2, wc = wid & 3, fr = lane & 15, fq = lane >> 4;
    const int nt = RB / (BK * 2);
    unsigned voffA[2], voffB[2];
#pragma unroll
    for (int i = 0; i < 2; ++i) { int R, C; stage_rc(tid * 16 + i * 8192, R, C); const int Rb = Epi::brow(R);
        voffA[i] = (unsigned)(R * RB + C * 2); voffB[i] = (unsigned)(Rb * RB + C * 2); }
    const size_t kstep = (size_t)(BK * 2);
    const size_t hstep = (size_t)HALF * RB;
    const size_t hstepB = (size_t)Epi::BSTEP * RB;
    const int wscale = wsc * 0x01010101, ascale = 0x7f7f7f7f;
    constexpr bool GATHER = Sched::GATHER;
    unsigned cvo[2][2] = {{0u, 0u}, {0u, 0u}}, nvo[2][2] = {{0u, 0u}, {0u, 0u}};
    int gR[2], gC[2];
#pragma unroll
    for (int i = 0; i < 2; ++i) { stage_rc(tid * 16 + i * 8192, gR[i], gC[i]); }
#define PG8_GTOK(u_, o_) do { const int e_ = (u_).aux, lb_ = (u_).pm * BM - S.est[e_], c_ = S.cntl[e_]; _Pragma("unroll") for (int h_ = 0; h_ < 2; ++h_) _Pragma("unroll") for (int i_ = 0; i_ < 2; ++i_) { const int lr_ = lb_ + h_ * HALF + gR[i_]; \
        o_[h_][i_] = lr_ < c_ ? (unsigned)S.list[(size_t)e_ * M + lr_].x : 0u; } } while (0)
#define PG8_GOFF(o_) do { _Pragma("unroll") for (int h_ = 0; h_ < 2; ++h_) _Pragma("unroll") for (int i_ = 0; i_ < 2; ++i_) o_[h_][i_] = o_[h_][i_] * (unsigned)RB + (unsigned)(gC[i_] * 2); } while (0)
#define PG8_STAGE_A(bufoff, gk, h) do { if constexpr (GATHER) { PG8_STAGE(bufoff, gk, cvo[h]); } else { PG8_STAGE(bufoff, (gk) + (h) * hstep, voffA); } } while (0)
    const unsigned ldsw = (unsigned)wid * 1024u;
    const int aoff = lds_byte(wr * 64 + fr, fq * 8), boff = lds_byte(wc * 32 + fr, fq * 8);
#define PG8_SA(b, h) (((b) * 2 + (h)) * HTB)
#define PG8_SB(b, h) ((4 + (b) * 2 + (h)) * HTB)
#define PG8_STAGE(bufoff, gbase, voff) do { _Pragma("unroll") for (int _i = 0; _i < 2; ++_i) \
        __builtin_amdgcn_global_load_lds((const unsigned*)((const char*)(gbase) + (voff)[_i]), (LAS unsigned*)(lds + (bufoff) + ldsw + _i * 8192), 16, 0, 0); } while (0)
#define PG8_LDA(dst, b, h) do { _Pragma("unroll") for (int m = 0; m < 4; ++m) _Pragma("unroll") for (int k = 0; k < 2; ++k) dst[m][k] = *(const LAS bf16x8*)(lds + PG8_SA(b, h) + aoff + m * 2048 + k * 1024); } while (0)
#define PG8_LDB(dst, b, h) do { _Pragma("unroll") for (int n = 0; n < 2; ++n) _Pragma("unroll") for (int k = 0; k < 2; ++k) dst[n][k] = *(const LAS bf16x8*)(lds + PG8_SB(b, h) + boff + n * 2048 + k * 1024); } while (0)
#define PG8_MMA(ai, bj, At, Bt) do { __builtin_amdgcn_s_setprio(1); _Pragma("unroll") for (int m = 0; m < 4; ++m) _Pragma("unroll") for (int n = 0; n < 2; ++n) { \
        if constexpr (MODE == 0) { _Pragma("unroll") for (int k = 0; k < 2; ++k) acc[ai][bj][m][n] = __builtin_amdgcn_mfma_f32_16x16x32_bf16(Bt[n][k], At[m][k], acc[ai][bj][m][n], 0, 0, 0); } \
        else if constexpr (MODE == 2) { _Pragma("unroll") for (int k = 0; k < 2; ++k) acc[ai][bj][m][n] = __builtin_bit_cast(f32x4, __builtin_amdgcn_mfma_i32_16x16x64_i8(__builtin_bit_cast(i32x4, Bt[n][k]), __builtin_bit_cast(i32x4, At[m][k]), __builtin_bit_cast(i32x4, acc[ai][bj][m][n]), 0, 0, 0)); } \
        else { const i32x8 b8_ = __builtin_shufflevector(__builtin_bit_cast(i32x4, Bt[n][0]), __builtin_bit_cast(i32x4, Bt[n][1]), 0, 1, 2, 3, 4, 5, 6, 7); \
               const i32x8 a8_ = __builtin_shufflevector(__builtin_bit_cast(i32x4, At[m][0]), __builtin_bit_cast(i32x4, At[m][1]), 0, 1, 2, 3, 4, 5, 6, 7); \
               asm volatile("v_mfma_scale_f32_16x16x128_f8f6f4 %0, %1, %2, %0, %3, %4 op_sel_hi:[0,0,0]" : "+v"(acc[ai][bj][m][n]) : "v"(b8_), "v"(a8_), "v"(wscale), "v"(ascale)); } } \
        __builtin_amdgcn_s_setprio(0); } while (0)
#define PG8_WAIT_V(n) asm volatile("s_waitcnt vmcnt(" #n ")" ::: "memory")
#define PG8_WAIT_L(n) asm volatile("s_waitcnt lgkmcnt(" #n ")" ::: "memory")
#define PG8_BAR __builtin_amdgcn_s_barrier()
#define PG8_SCHED __builtin_amdgcn_sched_barrier(0)
    Unit cur, nxt; int ui = 0;
    if (!S.next(0, cur)) return;
    f32x4 acc[2][2][4][2];
#pragma unroll
    for (int a = 0; a < 2; ++a)
#pragma unroll
        for (int b = 0; b < 2; ++b)
#pragma unroll
            for (int m = 0; m < 4; ++m)
#pragma unroll
                for (int n = 0; n < 2; ++n) acc[a][b][m][n] = (f32x4){0.f, 0.f, 0.f, 0.f};
    bf16x8 At[4][2], B0[2][2], B1[2][2];
    const char* cA = cur.A; const char* cB = cur.B;
    if constexpr (GATHER) { PG8_GTOK(cur, cvo); PG8_GOFF(cvo); }
    PG8_STAGE(PG8_SB(0, 0), cB, voffB); PG8_STAGE(PG8_SB(0, 1), cB + hstepB, voffB); PG8_STAGE_A(PG8_SA(0, 0), cA, 0); PG8_STAGE_A(PG8_SA(0, 1), cA, 1);
    if (wr == 1) PG8_BAR;
    PG8_WAIT_V(2); PG8_BAR;
    PG8_STAGE(PG8_SB(1, 0), cB + kstep, voffB); PG8_STAGE_A(PG8_SA(1, 0), cA + kstep, 0); PG8_STAGE(PG8_SB(1, 1), cB + hstepB + kstep, voffB);
    PG8_WAIT_V(6); PG8_BAR;
    for (;;) {
        const bool has_next = S.next(ui + 1, nxt);
        const char* nA = has_next ? nxt.A : cA; const char* nB = has_next ? nxt.B : cB;
        if constexpr (GATHER) { if (has_next) PG8_GTOK(nxt, nvo); }
        for (int t = 0; t < nt; t += 2) {
            const bool last = (t == nt - 2);
            const char* a1 = cA + (size_t)(t + 1) * kstep;
            const char* a2 = last ? nA : cA + (size_t)(t + 2) * kstep; const char* b2 = last ? nB : cB + (size_t)(t + 2) * kstep;
            const char* a3 = a2 + kstep; const char* b3 = b2 + kstep;
            PG8_LDB(B0, 0, 0); PG8_LDB(B1, 0, 1); PG8_SCHED; PG8_LDA(At, 0, 0); PG8_STAGE_A(PG8_SA(1, 1), a1, 1);
            if constexpr (GATHER) { if (last && has_next) {
                PG8_GOFF(nvo);
#pragma unroll
                for (int h_ = 0; h_ < 2; ++h_) { cvo[h_][0] = nvo[h_][0]; cvo[h_][1] = nvo[h_][1]; } } }
            PG8_WAIT_V(8); PG8_WAIT_L(0); PG8_BAR; PG8_MMA(0, 0, At, B0); PG8_MMA(0, 1, At, B1); PG8_BAR; PG8_SCHED;
            PG8_LDA(At, 0, 1); PG8_STAGE(PG8_SB(0, 0), b2, voffB); PG8_STAGE(PG8_SB(0, 1), b2 + hstepB, voffB); PG8_STAGE_A(PG8_SA(0, 0), a2, 0);
            PG8_WAIT_V(8); PG8_WAIT_L(0); PG8_BAR; PG8_MMA(1, 0, At, B0); PG8_MMA(1, 1, At, B1); PG8_BAR; PG8_SCHED;
            PG8_LDB(B0, 1, 0); PG8_LDB(B1, 1, 1); PG8_SCHED; PG8_LDA(At, 1, 0); PG8_STAGE_A(PG8_SA(0, 1), a2, 1);
            PG8_WAIT_V(8); PG8_WAIT_L(0); PG8_BAR; PG8_MMA(0, 0, At, B0); PG8_MMA(0, 1, At, B1); PG8_BAR; PG8_SCHED;
            PG8_LDA(At, 1, 1); PG8_STAGE(PG8_SB(1, 0), b3, voffB); PG8_STAGE(PG8_SB(1, 1), b3 + hstepB, voffB); PG8_STAGE_A(PG8_SA(1, 0), a3, 0);
            PG8_WAIT_V(8); PG8_WAIT_L(0); PG8_BAR; PG8_MMA(1, 0, At, B0); PG8_MMA(1, 1, At, B1); PG8_BAR; PG8_SCHED;
        }
        if constexpr (MODE == 1) asm volatile("s_nop 15\n\ts_nop 15" ::: "memory");
        if (wr == 0) PG8_BAR;
        E(acc, cur, wr, wc, fr, fq);
        if (!has_next) break;
#pragma unroll
        for (int a = 0; a < 2; ++a)
#pragma unroll
            for (int b = 0; b < 2; ++b)
#pragma unroll
                for (int m = 0; m < 4; ++m)
#pragma unroll
                    for (int n = 0; n < 2; ++n) acc[a][b][m][n] = (f32x4){0.f, 0.f, 0.f, 0.f};
        cur = nxt; cA = nA; cB = nB; ++ui;
        if (wr == 1) PG8_BAR;
    }
    PG8_WAIT_V(0);
    PG8_BAR;
#undef PG8_SA
#undef PG8_GOFF
#undef PG8_GTOK
#undef PG8_STAGE_A
#undef PG8_SB
#undef PG8_STAGE
#undef PG8_LDA
#undef PG8_LDB
#undef PG8_MMA
#undef PG8_WAIT_V
#undef PG8_WAIT_L
#undef PG8_BAR
#undef PG8_SCHED
}
}

namespace att {
enum { ORDER_NATURAL = 0, ORDER_REVERSED = 1, ORDER_PAIRED = 2, ORDER_XCD = 4 };
constexpr int D = 128;
constexpr int QP = NP1, KVP = NP1, OP = 16 * 256;
constexpr float THR = 8.f;
constexpr bool WSKIP = false;
constexpr float SCALE = 0.08838834764831845f;
constexpr int NW = 8, QBLK = 32, KVBLK = 64, QB = NW * QBLK;
constexpr int SHM_V = KVBLK * D * 2, SHM_K = KVBLK * D * 2;
constexpr int LDS_BYTES = 2 * SHM_V + 2 * SHM_K + NW * 64 * 4;
using bf16 = __hip_bfloat16;
template <class A, class Bt> struct same_t { static constexpr bool v = false; };
template <class A> struct same_t<A, A> { static constexpr bool v = true; };

#define KSWZ(row, colB) ((row) * 256 + ((colB) ^ (((row) & 7) << 4)))
#define SBAR() __builtin_amdgcn_sched_barrier(0)
__device__ __forceinline__ int v_st(int k, int c) { const int kk = (k & ~0xC) | ((k & 4) << 1) | ((k & 8) >> 1); return ((kk >> 3) * 4 + (c >> 5)) * 512 + ((kk & 7) * 32 + (c & 31)) * 2; }
__device__ __forceinline__ int v_rd_base(int lane) { return ((lane & 3) << 3) | (((lane >> 2) & 3) << 6) | (((lane >> 4) & 1) << 5) | (((lane >> 5) & 1) << 8); }
constexpr int v_rd_off(int d0, int ks, int half) { return d0 * 512 + ks * 4096 + half * 2048; }
__device__ __forceinline__ int crow(int r, int hi) { return (r & 3) + 8 * (r >> 2) + 4 * hi; }
__device__ __forceinline__ unsigned cvtpk(float lo, float hi) {
    unsigned r; asm volatile("v_cvt_pk_bf16_f32 %0, %1, %2" : "=v"(r) : "v"(lo), "v"(hi)); return r;
}
__device__ __forceinline__ bf16x8 pack8(f32x4 a, f32x4 b) {
    u32x4 w = {cvtpk(a[0], a[1]), cvtpk(a[2], a[3]), cvtpk(b[0], b[1]), cvtpk(b[2], b[3])};
    return *reinterpret_cast<bf16x8*>(&w);
}
template <class T> __device__ __forceinline__ bf16x8 load8(const T* p) {
    if constexpr (same_t<T, float>::v) { return pack8(*(const f32x4*)p, *(const f32x4*)(p + 4)); }
    else { return *reinterpret_cast<const bf16x8*>(p); }
}
__device__ __forceinline__ void mask_tile(f32x16& p0, f32x16& p1, int dq, unsigned W) {
    const float NEG = -__builtin_inff();
#pragma unroll
    for (int r = 0; r < 16; ++r) {
        const int c = (r & 3) + 8 * (r >> 2);
        if ((unsigned)(dq - c) >= W) p0[r] = NEG;
        if ((unsigned)(dq - c - 32) >= W) p1[r] = NEG;
    }
}
__device__ __forceinline__ void partialSM(f32x16& p0, f32x16& p1, float& m_reg, float& mn, float& alpha) {
    float pmax = p0[0]; for (int r = 1; r < 16; ++r) pmax = fmaxf(pmax, p0[r]); for (int r = 0; r < 16; ++r) pmax = fmaxf(pmax, p1[r]);
    { auto rr = __builtin_amdgcn_permlane32_swap(__float_as_uint(pmax), __float_as_uint(pmax), false, false);
      pmax = fmaxf(__uint_as_float(rr[0]), __uint_as_float(rr[1])); }
    constexpr float C2 = 1.4426950408889634f * SCALE;
    if (__builtin_expect(__all((pmax - m_reg) * SCALE <= THR), 1)) { mn = m_reg; alpha = 1.f; }
    else { mn = fmaxf(m_reg, pmax); alpha = __builtin_amdgcn_exp2f((m_reg - mn) * C2); m_reg = mn; }
    const float mnL = -mn * C2;
    for (int r = 0; r < 16; ++r) p0[r] = fmaf(p0[r], C2, mnL); for (int r = 0; r < 16; ++r) p1[r] = fmaf(p1[r], C2, mnL);
    for (int r = 0; r < 16; ++r) p0[r] = __builtin_amdgcn_exp2f(p0[r]);
}
__device__ __forceinline__ void finishSM(f32x16& p0, f32x16& p1, float alpha, float& l_reg, bf16x8& pa0, bf16x8& pa1, bf16x8& pa2, bf16x8& pa3) {
    for (int r = 0; r < 16; ++r) p1[r] = __builtin_amdgcn_exp2f(p1[r]);
    float ps = 0; for (int r = 0; r < 16; ++r) ps += p0[r]; for (int r = 0; r < 16; ++r) ps += p1[r];
    { auto rr = __builtin_amdgcn_permlane32_swap(__float_as_uint(ps), __float_as_uint(ps), false, false);
      ps = __uint_as_float(rr[0]) + __uint_as_float(rr[1]); }
    l_reg = l_reg * alpha + ps;
#define PK4(P, B_, OUT) do { unsigned a0 = cvtpk(P[B_+0], P[B_+1]), a1 = cvtpk(P[B_+2], P[B_+3]);                          \
        unsigned b0 = cvtpk(P[B_+4], P[B_+5]), b1 = cvtpk(P[B_+6], P[B_+7]);                                             \
        auto r0 = __builtin_amdgcn_permlane32_swap(a0, b0, false, false); auto r1 = __builtin_amdgcn_permlane32_swap(a1, b1, false, false); \
        u32x4 w = {r0[0], r1[0], r0[1], r1[1]}; OUT = *reinterpret_cast<bf16x8*>(&w); } while (0)
    PK4(p0, 0, pa0); PK4(p0, 8, pa1); PK4(p1, 0, pa2); PK4(p1, 8, pa3);
#undef PK4
}
template <int KB, bool SK>
__device__ __forceinline__ void qkt(f32x16& p0, f32x16& p1, const char* K_lds, int r32, int hi, const bf16x8* qr, bool act) {
    if (SK && !act) { const float NEG = -__builtin_inff();
#pragma unroll
        for (int r = 0; r < 16; ++r) { p0[r] = NEG; p1[r] = NEG; } return; }
    p0 = f32x16{}; p1 = f32x16{};
    const char* kb[4];
#pragma unroll
    for (int dd = 0; dd < 4; ++dd) kb[dd] = K_lds + KB * SHM_K + KSWZ(r32, (dd * 16 + hi * 8) * 2);
#pragma unroll
    for (int d0 = 0; d0 < 8; ++d0) { const char* a = kb[d0 & 3] + (d0 >> 2) * 128;
        bf16x8 b0 = *reinterpret_cast<const bf16x8*>(a);
        bf16x8 b1 = *reinterpret_cast<const bf16x8*>(a + 32 * 256);
        p0 = __builtin_amdgcn_mfma_f32_32x32x16_bf16(b0, qr[d0], p0, 0, 0, 0);
        p1 = __builtin_amdgcn_mfma_f32_32x32x16_bf16(b1, qr[d0], p1, 0, 0, 0); }
}
template <int VB, bool SK>
__device__ __forceinline__ void pv_tile(f32x16* o, int vb0, bf16x8 pa0, bf16x8 pa1, bf16x8 pa2, bf16x8 pa3, bool act) {
    if (SK && !act) return;
#define TRRD(dst, off) asm volatile("ds_read_b64_tr_b16 %0, %1 offset:%2" : "=&v"(dst) : "v"(vb0), "i"(off) : "memory")
#define PV_D0(d0) do { s16x4 l0, l1, l2, l3, h0, h1, h2, h3; constexpr int b_ = VB * SHM_V + v_rd_off(d0, 0, 0);     \
        TRRD(l0, b_); TRRD(h0, b_ + 2048); TRRD(l1, b_ + 4096); TRRD(h1, b_ + 6144); TRRD(l2, b_ + 8192); TRRD(h2, b_ + 10240); TRRD(l3, b_ + 12288); TRRD(h3, b_ + 14336); \
        asm volatile("s_waitcnt lgkmcnt(0)" ::: "memory"); SBAR();                 \
        o[d0] = __builtin_amdgcn_mfma_f32_32x32x16_bf16(pa0, (bf16x8){l0[0], l0[1], l0[2], l0[3], h0[0], h0[1], h0[2], h0[3]}, o[d0], 0, 0, 0);   \
        o[d0] = __builtin_amdgcn_mfma_f32_32x32x16_bf16(pa1, (bf16x8){l1[0], l1[1], l1[2], l1[3], h1[0], h1[1], h1[2], h1[3]}, o[d0], 0, 0, 0);   \
        o[d0] = __builtin_amdgcn_mfma_f32_32x32x16_bf16(pa2, (bf16x8){l2[0], l2[1], l2[2], l2[3], h2[0], h2[1], h2[2], h2[3]}, o[d0], 0, 0, 0);   \
        o[d0] = __builtin_amdgcn_mfma_f32_32x32x16_bf16(pa3, (bf16x8){l3[0], l3[1], l3[2], l3[3], h3[0], h3[1], h3[2], h3[3]}, o[d0], 0, 0, 0); } while (0)
    PV_D0(0); PV_D0(1); PV_D0(2); PV_D0(3);
#undef PV_D0
#undef TRRD
}

template <class TIn, class TOut> struct BlockRef { const TIn* Q; const TIn* K; const TIn* V; TOut* O; int P0; };
template <class TIn> struct Seam {
    bf16x8 qr[8];
    bf16x8 st_v0, st_v1, st_k0, st_k1; f32x4 sf0, sf1, sf2, sf3;
    f32x4 tq[16];
};
__device__ __forceinline__ int swa_jlo(int P0, int W) { const int lowk = P0 - W + 1; return lowk > 0 ? lowk / KVBLK : 0; }
#define ROW(p, k0, rr) ((p) + (size_t)((k0) + (rr)) * KVP + sc)
#define VMW() asm volatile("s_waitcnt vmcnt(0)" ::: "memory")
#define VMWN(n) asm volatile("s_waitcnt vmcnt(%0)" :: "i"(n) : "memory")
#define SLOAD_H(Kp, Vp, k0) do { const __amdgpu_buffer_rsrc_t rk_ = __builtin_amdgcn_make_buffer_rsrc((void*)(Kp), 0, 0x7fffffff, 0x00020000), rv_ = __builtin_amdgcn_make_buffer_rsrc((void*)(Vp), 0, 0x7fffffff, 0x00020000); const int so_ = (k0) * (KVP * 2); \
                         S.st_v0 = __builtin_bit_cast(bf16x8, __builtin_amdgcn_raw_buffer_load_b128(rv_, lo0, so_, 0)); S.st_v1 = __builtin_bit_cast(bf16x8, __builtin_amdgcn_raw_buffer_load_b128(rv_, lo1, so_, 0)); \
                         S.st_k0 = __builtin_bit_cast(bf16x8, __builtin_amdgcn_raw_buffer_load_b128(rk_, lo0, so_, 0)); S.st_k1 = __builtin_bit_cast(bf16x8, __builtin_amdgcn_raw_buffer_load_b128(rk_, lo1, so_, 0)); } while (0)
#define SWRITE_HK(bf) do { *(bf16x8*)(K_lds + (bf) * SHM_K + kws) = S.st_k0; *(bf16x8*)(K_lds + (bf) * SHM_K + kws + 32 * 256) = S.st_k1; } while (0)
#define SWRITE_HV(bf) do { *(bf16x8*)(V_lds + (bf) * SHM_V + vst0) = S.st_v0; *(bf16x8*)(V_lds + (bf) * SHM_V + vst1) = S.st_v1; } while (0)
#define SWRITE_H(bf) do { SWRITE_HV(bf); SWRITE_HK(bf); } while (0)
#define SLOAD_F(p, k0) do { S.sf0 = *(const f32x4*)ROW(p, k0, sr); S.sf1 = *(const f32x4*)(ROW(p, k0, sr) + 4);                \
                            S.sf2 = *(const f32x4*)ROW(p, k0, 32 + sr); S.sf3 = *(const f32x4*)(ROW(p, k0, 32 + sr) + 4); } while (0)
#define SWRITE_KF(bf) do { *(bf16x8*)(K_lds + (bf) * SHM_K + kws) = pack8(S.sf0, S.sf1); *(bf16x8*)(K_lds + (bf) * SHM_K + kws + 32 * 256) = pack8(S.sf2, S.sf3); } while (0)
#define SWRITE_VF(bf) do { *(bf16x8*)(V_lds + (bf) * SHM_V + vst0) = pack8(S.sf0, S.sf1); *(bf16x8*)(V_lds + (bf) * SHM_V + vst1) = pack8(S.sf2, S.sf3); } while (0)
template <class TIn, class TOut>
__device__ __forceinline__ void causal_swa_prime(const BlockRef<TIn, TOut>& cur, int W, char* lds, Seam<TIn>& S) {
    constexpr bool F32 = same_t<TIn, float>::v;
    const int tid = threadIdx.x, wid = __builtin_amdgcn_readfirstlane(tid >> 6), lane = tid & 63, r32 = lane & 31, hi = lane >> 5;
    const int sr = tid >> 4, sc = (tid & 15) * 8, kws = KSWZ(sr, sc * 2); char* K_lds = lds + 2 * SHM_V; const int lo0 = (sr * KVP + sc) * 2, lo1 = lo0 + 32 * KVP * 2;
    const int kb0 = swa_jlo(cur.P0, W) * KVBLK;
    { const __amdgpu_buffer_rsrc_t rq_ = __builtin_amdgcn_make_buffer_rsrc((void*)cur.Q, 0, 0x7fffffff, 0x00020000); const int qo_ = ((wid * QBLK + r32) * QP + hi * 8) * 2;
    _Pragma("unroll") for (int d0 = 0; d0 < 8; ++d0) S.qr[d0] = __builtin_bit_cast(bf16x8, __builtin_amdgcn_raw_buffer_load_b128(rq_, qo_ + d0 * 32, 0, 0)); }
    if constexpr (F32) { SLOAD_F((const float*)cur.K, kb0); VMW(); SWRITE_KF(0); SBAR(); SLOAD_F((const float*)cur.V, kb0); }
    else { SLOAD_H(cur.K, cur.V, kb0); VMW(); SWRITE_HK(0); }
    __syncthreads();
}
template <class TIn, class TOut>
__device__ __forceinline__ void causal_swa_block(const BlockRef<TIn, TOut>& cur, const BlockRef<TIn, TOut>& nxt, int skv, int W, char* lds, Seam<TIn>& S) {
    constexpr bool F32 = same_t<TIn, float>::v;
    const int tid = threadIdx.x, wid = __builtin_amdgcn_readfirstlane(tid >> 6), lane = tid & 63, r32 = lane & 31, hi = lane >> 5;
    const int j_lo = swa_jlo(cur.P0, W);
    int j_hi = (cur.P0 + QB - 1) / KVBLK + 1; if (j_hi > skv / KVBLK) j_hi = skv / KVBLK;
    const int NT = j_hi - j_lo;
    const int kbn = swa_jlo(nxt.P0, W) * KVBLK;
    const int qlo = cur.P0 + wid * QBLK, qm = qlo + r32 - 4 * hi;
    char* V_lds = lds; char* K_lds = lds + 2 * SHM_V;
    float* ws = (float*)(lds + 2 * SHM_V + 2 * SHM_K) + wid * 64; float* li_l = ws, * al_l = ws + 32;
    float m_reg = -1e30f, l_reg = 0; f32x16 o[4] = {};
    const int sr = tid >> 4, sc = (tid & 15) * 8, vst0 = v_st(sr, sc), vst1 = v_st(32 + sr, sc), kws = KSWZ(sr, sc * 2); const int lo0 = (sr * KVP + sc) * 2, lo1 = lo0 + 32 * KVP * 2;
    const int vb0 = (int)(uintptr_t)V_lds + v_rd_base(lane);
    const TIn* Kh = cur.K; const TIn* Vh = cur.V;
#define RESC(a) do { if (__any((a) < 1.f)) { if (hi == 0) al_l[r32] = (a); asm volatile("s_waitcnt lgkmcnt(0)" ::: "memory");              \
                     for (int d_ = 0; d_ < 4; ++d_) for (int r = 0; r < 16; ++r) o[d_][r] *= al_l[crow(r, hi)]; } } while (0)
#define KBASE(t) ((j_lo + (t)) * KVBLK)
#define ACT(t) (KBASE(t) <= qlo + QBLK - 1 && KBASE(t) + KVBLK - 1 >= qlo - W + 1)
#define MASKT(P0_, P1_, t) do { const int kb_ = KBASE(t); if ((!SK || ACT(t)) && (kb_ + KVBLK - 1 > qlo || kb_ <= qlo + QBLK - 1 - W)) mask_tile(P0_, P1_, qm - kb_, (unsigned)W); } while (0)
    constexpr int NQL = F32 ? 16 : 8;
    constexpr bool SK = WSKIP && !F32;
#define SEAM_K0() do { VMWN(NQL); if constexpr (F32) { SWRITE_KF(0); SBAR(); SLOAD_F((const float*)nxt.V, kbn); } else { SWRITE_HK(0); } SBAR(); } while (0)
    f32x16 pA0, pA1, pB0, pB1; float mnA, mnB, alA, alB; bf16x8 pa0, pa1, pa2, pa3;
    if constexpr (F32) { VMW(); SWRITE_VF(0); SBAR(); } else { SWRITE_HV(0); SBAR(); }
    if (NT > 1) { if constexpr (F32) SLOAD_F((const float*)Kh, KBASE(1)); else SLOAD_H(Kh, Vh, KBASE(1)); }
    SBAR(); qkt<0, SK>(pA0, pA1, K_lds, r32, hi, S.qr, ACT(0));
    if constexpr (F32) { if (NT > 1) { VMW(); SWRITE_KF(1); SBAR(); SLOAD_F((const float*)Vh, KBASE(1)); } }
    MASKT(pA0, pA1, 0); partialSM(pA0, pA1, m_reg, mnA, alA);
    if (NT > 1) { VMW(); if constexpr (F32) { SWRITE_VF(1); SBAR(); if (NT > 2) SLOAD_F((const float*)Kh, KBASE(2)); } else SWRITE_H(1); }
    __syncthreads();
#define HALF_STEP(PX0, PX1, mnX, alX, PY0, PY1, alY, t, KB, VB, SB) do {                                                      \
        SBAR(); qkt<KB, SK>(PX0, PX1, K_lds, r32, hi, S.qr, ACT(t));                                             \
        finishSM(PY0, PY1, alY, l_reg, pa0, pa1, pa2, pa3); SBAR();                                                           \
        if ((t) + 1 < NT) { if constexpr (F32) { VMW(); SWRITE_KF(SB); SBAR(); SLOAD_F((const float*)Vh, KBASE((t) + 1)); }  \
                            else { SLOAD_H(Kh, Vh, KBASE((t) + 1)); } SBAR(); }                                               \
        pv_tile<VB, SK>(o, vb0, pa0, pa1, pa2, pa3, ACT((t) - 1)); MASKT(PX0, PX1, (t)); partialSM(PX0, PX1, m_reg, mnX, alX);                                        \
        __syncthreads();                                                                                                      \
        if ((t) + 1 < NT) { VMW(); if constexpr (F32) { SWRITE_VF(SB); SBAR(); if ((t) + 2 < NT) SLOAD_F((const float*)Kh, KBASE((t) + 2)); } \
                            else { SWRITE_H(SB); } }                                                                          \
        RESC(alX); __syncthreads(); } while (0)
    for (int t = 1; t + 1 < NT; t += 2) {
        HALF_STEP(pB0, pB1, mnB, alB, pA0, pA1, alA, t, 1, 0, 0);
        HALF_STEP(pA0, pA1, mnA, alA, pB0, pB1, alB, t + 1, 0, 1, 1);
    }
    const bool even = (NT & 1) == 0;
    if (even) { SBAR(); qkt<1, SK>(pB0, pB1, K_lds, r32, hi, S.qr, ACT(NT - 1)); SBAR(); }
#define QROW(e) (nxt.Q + (size_t)(wid * QBLK + r32) * QP + ((e) >> 1) * 16 + hi * 8 + ((e) & 1) * 4)
    if constexpr (F32) { SLOAD_F((const float*)nxt.K, kbn); SBAR();
#pragma unroll
        for (int e = 0; e < 8; ++e) S.tq[e] = *(const f32x4*)QROW(e); }
    else { SLOAD_H(nxt.K, nxt.V, kbn); SBAR();
        { const __amdgpu_buffer_rsrc_t rq_ = __builtin_amdgcn_make_buffer_rsrc((void*)nxt.Q, 0, 0x7fffffff, 0x00020000); const int qo_ = ((wid * QBLK + r32) * QP + hi * 8) * 2;
        _Pragma("unroll") for (int d0 = 0; d0 < 8; ++d0) S.qr[d0] = __builtin_bit_cast(bf16x8, __builtin_amdgcn_raw_buffer_load_b128(rq_, qo_ + d0 * 32, 0, 0)); } }
    SBAR();
    finishSM(pA0, pA1, alA, l_reg, pa0, pa1, pa2, pa3); SBAR();
    if constexpr (F32) {
#pragma unroll
        for (int e = 8; e < 16; ++e) S.tq[e] = *(const f32x4*)QROW(e); SBAR(); }
#undef QROW
    pv_tile<0, SK>(o, vb0, pa0, pa1, pa2, pa3, ACT(even ? NT - 2 : NT - 1));
    if (even) { MASKT(pB0, pB1, NT - 1); partialSM(pB0, pB1, m_reg, mnB, alB); __syncthreads(); RESC(alB);
        finishSM(pB0, pB1, alB, l_reg, pa0, pa1, pa2, pa3); SBAR(); pv_tile<1, SK>(o, vb0, pa0, pa1, pa2, pa3, ACT(NT - 1)); }
    SBAR(); SEAM_K0();
    if (hi == 0) li_l[r32] = l_reg; asm volatile("s_waitcnt lgkmcnt(0)" ::: "memory");
    float rli[16];
#pragma unroll
    for (int r = 0; r < 16; ++r) rli[r] = __builtin_amdgcn_rcpf(li_l[crow(r, hi)]);
    TOut* Ow = cur.O + (size_t)(wid * QBLK) * OP;
#pragma unroll
    for (int r = 0; r < 16; ++r) { const int orow = crow(r, hi);
#pragma unroll
        for (int d0 = 0; d0 < 4; ++d0) { const float v = o[d0][r] * rli[r];
            if constexpr (same_t<TOut, float>::v) { Ow[(size_t)orow * OP + d0 * 32 + r32] = v; }
            else { const float vn = __shfl_xor(v, 1);
                   if ((r32 & 1) == 0) *(unsigned*)(Ow + (size_t)orow * OP + d0 * 32 + r32) = cvtpk(v, vn); } } }
    if constexpr (F32) {
#pragma unroll
        for (int d0 = 0; d0 < 8; ++d0) S.qr[d0] = pack8(S.tq[2 * d0], S.tq[2 * d0 + 1]); }
    __syncthreads();
#undef RESC
#undef KBASE
#undef ACT
#undef MASKT
#undef SEAM_K0
#undef HALF_STEP
}
#undef ROW
#undef VMW
#undef VMWN
#undef SLOAD_H
#undef SWRITE_HK
#undef SWRITE_HV
#undef SWRITE_H
#undef SLOAD_F
#undef SWRITE_KF
#undef SWRITE_VF

}

namespace att2 {
using att::bf16;
constexpr int D = 128, KVP = NP1, QP = NP1, OP = 16 * 256, KVBLK = 64, QB = 128;
constexpr int SHM = KVBLK * D * 2;
constexpr int L_K = 0, L_V = 2 * SHM, L_P = L_V + 4 * SHM, L_LI = L_P + 2 * 4 * 4096, L_END = L_LI + 1024;
static_assert(L_END <= RING_BYTES, "attention LDS");
constexpr float SCALE = 0.08838834764831845f, C2 = 1.4426950408889634f * SCALE;
struct Block { const bf16* Q; const bf16* K; const bf16* V; bf16* O; int P0; };
__device__ __forceinline__ u32x4 bload(__amdgpu_buffer_rsrc_t r, int voff, int soff) { return __builtin_bit_cast(u32x4, __builtin_amdgcn_raw_buffer_load_b128(r, voff, soff, 0)); }
#define A2_TRRD(dst, base, off) asm volatile("ds_read_b64_tr_b16 %0, %1 offset:%2" : "=&v"(dst) : "v"(base), "i"(off) : "memory")
#define A2_PV(o_, vbase, IMG, d0) do { s16x4 l0, l1, l2, l3, h0, h1, h2, h3; constexpr int b_ = (IMG) + att::v_rd_off(d0, 0, 0); \
        A2_TRRD(l0, vbase, b_); A2_TRRD(h0, vbase, b_ + 2048); A2_TRRD(l1, vbase, b_ + 4096); A2_TRRD(h1, vbase, b_ + 6144); A2_TRRD(l2, vbase, b_ + 8192); A2_TRRD(h2, vbase, b_ + 10240); A2_TRRD(l3, vbase, b_ + 12288); A2_TRRD(h3, vbase, b_ + 14336); \
        asm volatile("s_waitcnt lgkmcnt(0)" ::: "memory"); __builtin_amdgcn_sched_barrier(0); \
        o_ = __builtin_amdgcn_mfma_f32_32x32x16_bf16(pa0, (bf16x8){l0[0], l0[1], l0[2], l0[3], h0[0], h0[1], h0[2], h0[3]}, o_, 0, 0, 0); \
        o_ = __builtin_amdgcn_mfma_f32_32x32x16_bf16(pa1, (bf16x8){l1[0], l1[1], l1[2], l1[3], h1[0], h1[1], h1[2], h1[3]}, o_, 0, 0, 0); \
        o_ = __builtin_amdgcn_mfma_f32_32x32x16_bf16(pa2, (bf16x8){l2[0], l2[1], l2[2], l2[3], h2[0], h2[1], h2[2], h2[3]}, o_, 0, 0, 0); \
        o_ = __builtin_amdgcn_mfma_f32_32x32x16_bf16(pa3, (bf16x8){l3[0], l3[1], l3[2], l3[3], h3[0], h3[1], h3[2], h3[3]}, o_, 0, 0, 0); } while (0)
#define A2_PK4(P, B_, OUT) do { unsigned a0_ = att::cvtpk(P[B_+0], P[B_+1]), a1_ = att::cvtpk(P[B_+2], P[B_+3]), b0_ = att::cvtpk(P[B_+4], P[B_+5]), b1_ = att::cvtpk(P[B_+6], P[B_+7]); \
        auto r0_ = __builtin_amdgcn_permlane32_swap(a0_, b0_, false, false); auto r1_ = __builtin_amdgcn_permlane32_swap(a1_, b1_, false, false); \
        u32x4 w_ = {r0_[0], r1_[0], r0_[1], r1_[1]}; OUT = __builtin_bit_cast(bf16x8, w_); } while (0)
__device__ __forceinline__ void block(const Block& B, char* lds, const float mref) {
    const int tid = threadIdx.x, wid = __builtin_amdgcn_readfirstlane(tid >> 6), lane = tid & 63, r32 = lane & 31, hi = lane >> 5; const int rg = wid & 3, kh = wid >> 2;
    const int NT = B.P0 / KVBLK + 2;
    const int qlo = B.P0 + rg * 32, qm = qlo + r32 - 4 * hi;
    const int sr = tid >> 4, sc = (tid & 15) * 8, kws = KSWZ(sr, sc * 2), vst0 = att::v_st(sr, sc), vst1 = att::v_st(32 + sr, sc);
    const int lo0 = (sr * KVP + sc) * 2, lo1 = lo0 + 32 * KVP * 2;
    const __amdgpu_buffer_rsrc_t rk = __builtin_amdgcn_make_buffer_rsrc((void*)B.K, 0, 0x7fffffff, 0x00020000), rv = __builtin_amdgcn_make_buffer_rsrc((void*)B.V, 0, 0x7fffffff, 0x00020000);
    const int vb0 = (int)(uintptr_t)(lds + L_V + kh * SHM) + att::v_rd_base(lane);
    char* Pmine = lds + L_P + rg * 4096 + (2 * kh) * 1024 + lane * 16;
    const char* Ppart = lds + L_P + rg * 4096 + (2 * (kh ^ 1)) * 1024 + lane * 16;
    u32x4 sk0, sk1, sa0, sa1, sb0, sb1;
#define A2_LOADK(t_) do { const int so_ = (t_) * KVBLK * KVP * 2; sk0 = bload(rk, lo0, so_); sk1 = bload(rk, lo1, so_); } while (0)
#define A2_LOADV(t_) do { const int so_ = (t_) * KVBLK * KVP * 2; sa0 = bload(rv, lo0, so_); sa1 = bload(rv, lo1, so_); sb0 = bload(rv, lo0 + 256, so_); sb1 = bload(rv, lo1 + 256, so_); } while (0)
#define A2_WRITEK(par) do { *(u32x4*)(lds + L_K + (par) * SHM + kws) = sk0; *(u32x4*)(lds + L_K + (par) * SHM + kws + 32 * 256) = sk1; } while (0)
#define A2_WRITEV(par) do { char* v_ = lds + L_V + (par) * 2 * SHM; *(u32x4*)(v_ + vst0) = sa0; *(u32x4*)(v_ + vst1) = sa1; *(u32x4*)(v_ + SHM + vst0) = sb0; *(u32x4*)(v_ + SHM + vst1) = sb1; } while (0)
    bf16x8 qr[8]; f32x16 o[4] = {}; float l_reg = 0.f; bf16x8 my0, my1;
    A2_LOADK(0);
    u32x4 tk0 = bload(rk, lo0, KVBLK * KVP * 2), tk1 = bload(rk, lo1, KVBLK * KVP * 2);
    A2_LOADV(0);
    { const __amdgpu_buffer_rsrc_t rq = __builtin_amdgcn_make_buffer_rsrc((void*)B.Q, 0, 0x7fffffff, 0x00020000); const int qo = ((rg * 32 + r32) * QP + hi * 8) * 2;
#pragma unroll
      for (int d0 = 0; d0 < 8; ++d0) qr[d0] = __builtin_bit_cast(bf16x8, bload(rq, qo + d0 * 32, 0)); }
    asm volatile("s_waitcnt vmcnt(0)" ::: "memory");
    A2_WRITEK(0);
    sk0 = tk0; sk1 = tk1;
    __syncthreads();
    for (int t = 0; t <= NT; ++t) {
        const bool sc_ = t < NT, k1 = t + 1 < NT;
        asm volatile("s_waitcnt vmcnt(0)" ::: "memory");
        if (k1) A2_WRITEK((t + 1) & 1);
        if (sc_) A2_WRITEV(t & 1);
        if (t + 2 < NT) A2_LOADK(t + 2);
        if (k1) A2_LOADV(t + 1);
        bf16x8 pv0 = my0, pv1 = my1;
        if (sc_) {
            const int kb0 = t * KVBLK + 32 * kh;
            if (kb0 > qlo + 31) { my0 = bf16x8{}; my1 = bf16x8{}; }
            else {
                f32x16 p = {}; const char* kb_[4];
#pragma unroll
                for (int dd = 0; dd < 4; ++dd) kb_[dd] = lds + L_K + (t & 1) * SHM + kh * 32 * 256 + KSWZ(r32, (dd * 16 + hi * 8) * 2);
#pragma unroll
                for (int d0 = 0; d0 < 8; ++d0) p = __builtin_amdgcn_mfma_f32_32x32x16_bf16(*reinterpret_cast<const bf16x8*>(kb_[d0 & 3] + (d0 >> 2) * 128), qr[d0], p, 0, 0, 0);
                if (kb0 + 31 > qlo) { const int dq = qm - kb0; const float NEG = -__builtin_inff();
#pragma unroll
                    for (int r = 0; r < 16; ++r) { const int c = (r & 3) + 8 * (r >> 2); if ((unsigned)(dq - c) >= (unsigned)SEQ) p[r] = NEG; } }
                const float mnl = -mref * C2; float ps = 0.f;
#pragma unroll
                for (int r = 0; r < 16; ++r) { p[r] = __builtin_amdgcn_exp2f(fmaf(p[r], C2, mnl)); ps += p[r]; }
                { auto rr = __builtin_amdgcn_permlane32_swap(__float_as_uint(ps), __float_as_uint(ps), false, false); l_reg += __uint_as_float(rr[0]) + __uint_as_float(rr[1]); }
                A2_PK4(p, 0, my0); A2_PK4(p, 8, my1);
            }
            char* pw = Pmine + (t & 1) * 4 * 4096; *(bf16x8*)pw = my0; *(bf16x8*)(pw + 1024) = my1;
        }
        if (t >= 1 && (t - 1) * KVBLK <= qlo + 31) {
            const char* pr = Ppart + ((t - 1) & 1) * 4 * 4096; const bf16x8 ot0 = *(const bf16x8*)pr, ot1 = *(const bf16x8*)(pr + 1024);
            const bf16x8 pa0 = kh ? ot0 : pv0, pa1 = kh ? ot1 : pv1, pa2 = kh ? pv0 : ot0, pa3 = kh ? pv1 : ot1;
            const int vb = vb0 + ((t - 1) & 1) * 2 * SHM;
            A2_PV(o[0], vb, 0, 0); A2_PV(o[1], vb, 0, 1); A2_PV(o[2], vb, 0, 2); A2_PV(o[3], vb, 0, 3);
        }
        __syncthreads();
    }
    float* li = (float*)(lds + L_LI);
    if (hi == 0) li[(kh * 4 + rg) * 32 + r32] = l_reg;
    __syncthreads();
    float rli[16];
#pragma unroll
    for (int r = 0; r < 16; ++r) rli[r] = __builtin_amdgcn_rcpf(li[rg * 32 + att::crow(r, hi)] + li[(4 + rg) * 32 + att::crow(r, hi)]);
    bf16* Ow = B.O + (size_t)(rg * 32) * OP + kh * 128;
#pragma unroll
    for (int d0 = 0; d0 < 4; ++d0)
#pragma unroll
        for (int r = 0; r < 16; ++r) { const float v = o[d0][r] * rli[r]; const float vn = __shfl_xor(v, 1);
            if ((r32 & 1) == 0) *(unsigned*)(Ow + (size_t)att::crow(r, hi) * OP + d0 * 32 + r32) = att::cvtpk(v, vn); }
    __syncthreads();
#undef A2_LOADK
#undef A2_LOADV
#undef A2_WRITEK
#undef A2_WRITEV
}
#undef A2_PK4
#undef A2_TRRD
#undef A2_PV
}

#define XB_TMO      128
#define XB_XCNT(j)  (256  + 64 * (j))
#define XB_XSUB(j)  (1280 + 64 * (j))
#define XB_XGEN(j)  (2304 + 64 * (j))
#define XB_TOP      3328
#define XB_TOPGEN   3392
#define XCD_BAR_WORDS 3456
#define XB_SPIN_CAP (1u << 18)
__device__ __forceinline__ unsigned xb_ld(unsigned* p)              { return __hip_atomic_load(p, __ATOMIC_RELAXED, __HIP_MEMORY_SCOPE_AGENT); }
__device__ __forceinline__ unsigned xb_add(unsigned* p, unsigned v) { return __hip_atomic_fetch_add(p, v, __ATOMIC_RELAXED, __HIP_MEMORY_SCOPE_AGENT); }
__device__ __forceinline__ unsigned xb_xcc_id() { return (unsigned)__builtin_amdgcn_s_getreg((3 << 11) | 20) & 0xFu; }
#define XB_SPIN(cond, bar) do { unsigned _sp = 0; while (cond) { __builtin_amdgcn_s_sleep(1); \
    if ((++_sp & 255u) == 0u) { if (xb_ld(&(bar)[XB_TMO])) break; if (_sp > XB_SPIN_CAP) { atomicAdd(&(bar)[XB_TMO], 1u); break; } } } } while (0)
struct XcdBarrier { unsigned* bar; unsigned x; volatile LAS unsigned* st; };
__device__ __forceinline__ XcdBarrier xcd_barrier_post(unsigned* bar, volatile LAS unsigned* st) {
    XcdBarrier b; b.bar = bar; b.x = xb_xcc_id(); b.st = st;
    if (threadIdx.x == 0) (void)xb_add(&bar[XB_XCNT(b.x)], 1u);
    return b;
}
__device__ __forceinline__ void xcd_barrier_complete(unsigned* bar, unsigned x, unsigned& nloc, unsigned& nx) {
    const unsigned G = gridDim.x * gridDim.y * gridDim.z;
    unsigned sum, cnt, mine, sp = 0u;
    for (;;) {
        sum = 0u; cnt = 0u; mine = 0u;
#pragma unroll
        for (unsigned j = 0; j < 16; ++j) { const unsigned c = xb_ld(&bar[XB_XCNT(j)]); sum += c; cnt += (c > 0u) ? 1u : 0u; mine = (j == x) ? c : mine; }
        if (sum == G) break;
        __builtin_amdgcn_s_sleep(1);
        if ((++sp & 255u) == 0u) { if (xb_ld(&bar[XB_TMO])) break; if (sp > XB_SPIN_CAP) { atomicAdd(&bar[XB_TMO], 1u); break; } }
    }
    nloc = mine > 0u ? mine : 1u; nx = cnt > 0u ? cnt : 1u;
}
__device__ __forceinline__ void xcd_barrier(const XcdBarrier& b) {
    asm volatile("s_waitcnt vmcnt(0)" ::: "memory");
    __syncthreads();
    if (threadIdx.x == 0) {
        unsigned* bar = b.bar;
        __builtin_amdgcn_s_waitcnt(0);
        unsigned nloc = b.st[0], nx = b.st[1];
        if (nloc == 0u) { xcd_barrier_complete(bar, b.x, nloc, nx); b.st[0] = nloc; b.st[1] = nx; }
        const unsigned old = xb_add(&bar[XB_XSUB(b.x)], 1u);
        const unsigned gen = old / nloc;
        if (old + 1u == (gen + 1u) * nloc) {
            __builtin_amdgcn_fence(__ATOMIC_RELEASE, "agent");
            asm volatile("s_waitcnt vmcnt(0)" ::: "memory");
            const unsigned og = xb_add(&bar[XB_TOP], 1u);
            const unsigned tg = og / nx;
            if (og + 1u == (tg + 1u) * nx) xb_add(&bar[XB_TOPGEN], 1u);
            else XB_SPIN(xb_ld(&bar[XB_TOPGEN]) == tg, bar);
            __builtin_amdgcn_fence(__ATOMIC_ACQUIRE, "agent");
            xb_add(&bar[XB_XGEN(b.x)], 1u);
            asm volatile("s_waitcnt vmcnt(0)" ::: "memory");
        } else {
            XB_SPIN(xb_ld(&bar[XB_XGEN(b.x)]) == gen, bar);
            __builtin_amdgcn_fence(__ATOMIC_ACQUIRE, "agent");
            asm volatile("s_waitcnt vmcnt(0)" ::: "memory");
        }
    }
    __syncthreads();
}

#define LDS_WAIT() asm volatile("s_waitcnt lgkmcnt(0)" ::: "memory")
#define VM_WAIT() asm volatile("s_waitcnt vmcnt(0)" ::: "memory")
struct Inputs {
    const float* x; const int* positions; const float* mix_norm; const float* ffn_norm; const float* hgrn_w_in; const float* hgrn_out_gain; const float* hgrn_w_out; const float* hgrn_lb;
    const float* diff_w_in; const float* diff_q_gain; const float* diff_k_gain; const float* diff_lambda; const float* diff_sub_gain; const float* diff_w_out;
    const float* moe_w_group; const float* moe_w_expert; const float* moe_w_gate; const float* moe_w_up; const float* moe_w_down;
};
struct Args { Inputs in; float* out; unsigned char* ws; int ph_lo, ph_hi; };
typedef const CAS Args* KArgs;
__device__ __forceinline__ KArgs kargs() { KArgs p = (KArgs)__builtin_amdgcn_kernarg_segment_ptr(); asm volatile("" : "+s"(p)); return p; }
struct Frame {
    LAS unsigned char* lds;
    int wave, vcu, G;
    __device__ __forceinline__ int tid() const { return (int)threadIdx.x; }
    __device__ __forceinline__ int lane() const { return (int)threadIdx.x & 63; }
    __device__ __forceinline__ unsigned char* ws() const { return kargs()->ws; }
    __device__ __forceinline__ unsigned* ctl() const { return (unsigned*)(kargs()->ws + WS_CTL); }
};
__device__ __forceinline__ float wave_sum(float v) {
#pragma unroll
    for (int o = 1; o < 64; o <<= 1) v += __shfl_xor(v, o);
    return v;
}
struct TileDesc { const float* W; unsigned char* WT; const unsigned* colmax; int ldw, ldt, k0, n0; float wmul; };
struct TileRegs { f32x4 a[16]; };
template <int MODE> __device__ __forceinline__ void tile_load(const TileDesc& t, TileRegs& R, int lane) {
    if constexpr (MODE == 0) { const int l16 = lane & 15, g = lane >> 4;
#pragma unroll
        for (int it = 0; it < 8; ++it) { const int kp = it * 4 + g; const float* p = t.W + (size_t)(t.k0 + 2 * kp) * t.ldw + t.n0 + 4 * l16; R.a[2 * it] = __builtin_nontemporal_load((const f32x4*)p); R.a[2 * it + 1] = __builtin_nontemporal_load((const f32x4*)(p + t.ldw)); }
    } else { const int l8 = lane & 7, g = lane >> 3;
#pragma unroll
        for (int it = 0; it < 4; ++it) { const int kp = it * 8 + g; const float* p = t.W + (size_t)(t.k0 + 4 * kp) * t.ldw + t.n0 + 4 * l8;
#pragma unroll
            for (int q = 0; q < 4; ++q) R.a[4 * it + q] = __builtin_nontemporal_load((const f32x4*)(p + (size_t)q * t.ldw)); } }
}
template <int MODE> __device__ __forceinline__ void tile_finish(const TileDesc& t, const TileRegs& R, LAS unsigned* scr, int lane) {
    if constexpr (MODE == 0) { const int l16 = lane & 15, g = lane >> 4;
#pragma unroll
        for (int it = 0; it < 8; ++it) { const int kp = it * 4 + g;
#pragma unroll
            for (int j = 0; j < 4; ++j) scr[(4 * l16 + j) * 33 + kp] = cvt_pk_bf16(R.a[2 * it][j], R.a[2 * it + 1][j]); }
        LDS_WAIT(); asm volatile("" ::: "memory");
        const int ch = lane & 7;
#pragma unroll
        for (int jj = 0; jj < 8; ++jj) { const int n = (lane >> 3) + 8 * jj; const LAS unsigned* sp = scr + n * 33 + 4 * ch;
            u32x4 o; o.x = sp[0]; o.y = sp[1]; o.z = sp[2]; o.w = sp[3];
            __builtin_nontemporal_store(o, (u32x4*)(t.WT + ((size_t)n * t.ldt + t.k0 + 8 * ch) * 2)); }
    } else { const int l8 = lane & 7, g = lane >> 3;
        float inv[4];
        if constexpr (MODE == 2) {
#pragma unroll
            for (int j = 0; j < 4; ++j) { const float cm = __uint_as_float(t.colmax[t.n0 + 4 * l8 + j]); inv[j] = cm > 0.f ? 127.0f / cm : 0.f; } }
#pragma unroll
        for (int it = 0; it < 4; ++it) { const int kp = it * 8 + g;
#pragma unroll
            for (int j = 0; j < 4; ++j) {
                if constexpr (MODE == 1) scr[(4 * l8 + j) * 33 + kp] = pk4_fp8(R.a[4 * it][j] * t.wmul, R.a[4 * it + 1][j] * t.wmul, R.a[4 * it + 2][j] * t.wmul, R.a[4 * it + 3][j] * t.wmul);
                else { const int q0 = (int)rintf(R.a[4 * it][j] * inv[j]), q1 = (int)rintf(R.a[4 * it + 1][j] * inv[j]), q2 = (int)rintf(R.a[4 * it + 2][j] * inv[j]), q3 = (int)rintf(R.a[4 * it + 3][j] * inv[j]);
                       scr[(4 * l8 + j) * 33 + kp] = (unsigned)(q0 & 0xff) | ((unsigned)(q1 & 0xff) << 8) | ((unsigned)(q2 & 0xff) << 16) | ((unsigned)q3 << 24); } } }
        LDS_WAIT(); asm volatile("" ::: "memory");
        const int ch = lane & 7;
#pragma unroll
        for (int jj = 0; jj < 4; ++jj) { const int n = (lane >> 3) + 8 * jj; const LAS unsigned* sp = scr + n * 33 + 4 * ch;
            u32x4 o; o.x = sp[0]; o.y = sp[1]; o.z = sp[2]; o.w = sp[3];
            __builtin_nontemporal_store(o, (u32x4*)(t.WT + (size_t)n * t.ldt + t.k0 + 16 * ch)); } }
    LDS_WAIT(); asm volatile("" ::: "memory");
}
template <int MODE> __device__ __forceinline__ TileDesc tile_desc(const float* W, int ldw, int N, void* WT, int ldt, int t, int rowadd, float wmul, const unsigned* colmax) {
    constexpr int NT = MODE ? 32 : 64, KT = MODE ? 128 : 64, ES = MODE ? 1 : 2;
    const int ntn = N / NT, kt = t / ntn, n0 = (t % ntn) * NT;
    TileDesc d; d.W = W; d.WT = (unsigned char*)WT + (size_t)(n0 + rowadd) * ldt * ES; d.colmax = colmax; d.ldw = ldw; d.ldt = ldt; d.k0 = kt * KT; d.n0 = n0; d.wmul = wmul; return d;
}
template <int MODE, class Fn> __device__ __forceinline__ void conv_loop(const int n_items, const int worker, const int nworkers, const Fn& desc, LAS unsigned* scr, const int lane) {
    int it = worker; if (it >= n_items) return;
    TileRegs R0, R1; TileDesc d0 = desc(it), d1 = d0; tile_load<MODE>(d0, R0, lane);
    for (;;) {
        const int it1 = it + nworkers; const bool h1 = it1 < n_items; if (h1) { d1 = desc(it1); tile_load<MODE>(d1, R1, lane); }
        tile_finish<MODE>(d0, R0, scr, lane);
        if (!h1) break;
        const int it2 = it1 + nworkers; const bool h2 = it2 < n_items; if (h2) { d0 = desc(it2); tile_load<MODE>(d0, R0, lane); }
        tile_finish<MODE>(d1, R1, scr, lane);
        if (!h2) break;
        it = it2;
    }
}
template <int MODE, class Fn> __device__ __forceinline__ void conv_loop_dyn(const int n_items, unsigned* ctr, const Fn& desc, LAS unsigned* scr, const int lane) {
#define CQ_PULL() ({ int v_ = 0; if (lane == 0) v_ = (int)__hip_atomic_fetch_add(ctr, 1u, __ATOMIC_RELAXED, __HIP_MEMORY_SCOPE_AGENT); __builtin_amdgcn_readfirstlane(v_); })
    int it = CQ_PULL(); if (it >= n_items) return;
    TileRegs R0, R1; TileDesc d0 = desc(it), d1 = d0; tile_load<MODE>(d0, R0, lane);
    int it1 = CQ_PULL();
    for (;;) {
        const bool h1 = it1 < n_items; int it2 = n_items; if (h1) { d1 = desc(it1); tile_load<MODE>(d1, R1, lane); it2 = CQ_PULL(); }
        tile_finish<MODE>(d0, R0, scr, lane);
        if (!h1) break;
        const bool h2 = it2 < n_items; int it3 = n_items; if (h2) { d0 = desc(it2); tile_load<MODE>(d0, R0, lane); it3 = CQ_PULL(); }
        tile_finish<MODE>(d1, R1, scr, lane);
        if (!h2) break;
        it1 = it3;
    }
#undef CQ_PULL
}
struct DescIn { int set; KArgs ka; unsigned* ctl;
    __device__ __forceinline__ TileDesc operator()(int t) const { unsigned char* ws = ka->ws;
        return set == 0 ? tile_desc<INPROJ_MODE>(ka->in.hgrn_w_in, NP0, NP0, ws + WS_WHIN, D, t, 0, (float)(1 << WSH_IN), ctl + CW_CMAX + CSC_HIN)
                        : tile_desc<INPROJ_MODE>(ka->in.diff_w_in, NP1, NP1, ws + WS_WDIN, D, t, 0, (float)(1 << WSH_IN), ctl + CW_CMAX + CSC_DIN); } };
struct DescOutI8 { KArgs ka; unsigned* ctl;
    __device__ __forceinline__ TileDesc operator()(int t) const { return tile_desc<2>(ka->in.diff_w_out, D, D, ka->ws + WS_WDOUT, D, t, 0, 1.f, ctl + CW_CMAX + CSC_DOUT); } };
struct DescOut { int set; KArgs ka;
    __device__ __forceinline__ TileDesc operator()(int t) const { unsigned char* ws = ka->ws;
        return tile_desc<(FP8_OUTPROJ ? 1 : 0)>(set == 0 ? ka->in.hgrn_w_out : ka->in.diff_w_out, D, D, ws + (set == 0 ? WS_WHOUT : WS_WDOUT), D, t, 0, (float)(1 << WSH_OUT), nullptr); } };
struct DescMoe { int set; KArgs ka;
    __device__ __forceinline__ TileDesc operator()(int r) const { unsigned char* ws = ka->ws;
        constexpr int T_MOE1 = NE * 256, MM = FP8_MOE ? 1 : 0, MESZ = FP8_MOE ? 1 : 2;
        const int which = r / T_MOE1; r -= which * T_MOE1; const int le = set * NE + r / 256, t = r % 256;
        if (which < 2) {
            constexpr int NT = FP8_MOE ? 32 : 64; const int n0 = (t % (FF / NT)) * NT; const int rowadd = (n0 / 128) * 256 + (n0 % 128) + which * 128 - n0;
            return tile_desc<MM>((which == 0 ? ka->in.moe_w_gate : ka->in.moe_w_up) + (size_t)le * D * FF, FF, FF, ws + WS_WGU + (size_t)le * 1024 * D * MESZ, D, t, rowadd, (float)(1 << WSH_GU), nullptr); }
        return tile_desc<MM>(ka->in.moe_w_down + (size_t)le * FF * D, D, D, ws + WS_WDN + (size_t)le * D * FF * MESZ, FF, t, 0, (float)(1 << WSH_DN), nullptr); } };
__device__ __forceinline__ void convert_weights(Frame& F, const int set, const int worker, const int nworkers, LAS unsigned* scr, const int pct_lo = 0, const int pct_hi = 100) {
    const KArgs ka = kargs(); const int lane = F.lane();
    if (pct_lo == 0 || pct_lo == -1) {
        conv_loop<INPROJ_MODE>(set == 0 ? 32 * 128 : 32 * 96, worker, nworkers, DescIn{set, ka, F.ctl()}, scr, lane);
        if (OUT1_I8 && set == 1) conv_loop<2>(16 * 64, worker, nworkers, DescOutI8{ka, F.ctl()}, scr, lane);
        else conv_loop<(FP8_OUTPROJ ? 1 : 0)>(32 * 32, worker, nworkers, DescOut{set, ka}, scr, lane); }
    constexpr int NM = 3 * NE * 256;
    if (pct_lo < 0) { conv_loop_dyn<(FP8_MOE ? 1 : 0)>(NM, F.ctl() + CW_QUEUE, DescMoe{set, ka}, scr, lane); return; }
    const int i0 = (int)((long)NM * pct_lo / 100), i1 = (int)((long)NM * pct_hi / 100);
    conv_loop<(FP8_MOE ? 1 : 0)>(i1, i0 + worker, nworkers, DescMoe{set, ka}, scr, lane);
}
__device__ __forceinline__ void colmax_phase(Frame& F) {
    const CAS Inputs& I = kargs()->in;
    unsigned* cm = F.ctl() + CW_CMAX;
    const int gw = F.vcu * NWAVES + F.wave, NGW = F.G * NWAVES, lane = F.lane();
    constexpr int KS = 64, KR = D / KS;
    constexpr int B_HIN = NP0 / 256, B_HOUT = D / 256, B_DIN = NP1 / 256, B_DOUT = D / 256, NTASK = (B_HIN + B_HOUT + B_DIN + B_DOUT) * KS;
    for (int task = gw; task < NTASK; task += NGW) {
        int cb = task / KS; const int ks = task % KS; const float* W; int N, off;
        if (cb < B_HIN) { W = I.hgrn_w_in; N = NP0; off = CSC_HIN; } else if ((cb -= B_HIN) < B_HOUT) { continue; }
        else if ((cb -= B_HOUT) < B_DIN) { W = I.diff_w_in; N = NP1; off = CSC_DIN; } else { cb -= B_DIN; W = I.diff_w_out; N = D; off = CSC_DOUT; }
        const float* p = W + (size_t)(ks * KR) * N + cb * 256 + 4 * lane; f32x4 m = {0.f, 0.f, 0.f, 0.f};
#pragma unroll 8
        for (int r = 0; r < KR; ++r) { const f32x4 x = __builtin_nontemporal_load((const f32x4*)(p + (size_t)r * N)); m[0] = fmaxf(m[0], fabsf(x[0])); m[1] = fmaxf(m[1], fabsf(x[1])); m[2] = fmaxf(m[2], fabsf(x[2])); m[3] = fmaxf(m[3], fabsf(x[3])); }
#pragma unroll
        for (int j = 0; j < 4; ++j) atomicMax(cm + off + cb * 256 + 4 * lane + j, __float_as_uint(m[j]));
    }
}
__device__ __forceinline__ void norm_regs(const f32x4 (&vin)[8], bf16_t* __restrict__ xn, const float* __restrict__ gain, int lane, const int xn_mode, float* __restrict__ xn_scale) {
    f32x4 v[8]; float s = 0.f;
#pragma unroll
    for (int j = 0; j < 8; ++j) { v[j] = vin[j]; s += (v[j][0] * v[j][0] + v[j][1] * v[j][1]) + (v[j][2] * v[j][2] + v[j][3] * v[j][3]); }
    const float rstd = 1.0f / sqrtf(wave_sum(s) * (1.f / D) + NORM_EPS);
    if (xn_mode == 2) {
        float amax = 0.f;
#pragma unroll
        for (int j = 0; j < 8; ++j) { const f32x4 g = *((const f32x4*)gain + 64 * j + lane); v[j] = v[j] * rstd * g;
            amax = fmaxf(fmaxf(amax, fmaxf(fabsf(v[j][0]), fabsf(v[j][1]))), fmaxf(fabsf(v[j][2]), fabsf(v[j][3]))); }
#pragma unroll
        for (int o = 1; o < 64; o <<= 1) amax = fmaxf(amax, __shfl_xor(amax, o));
        const float inv = amax > 0.f ? 127.0f / amax : 0.f;
#pragma unroll
        for (int j = 0; j < 8; ++j) { const int q0 = (int)rintf(v[j][0] * inv), q1 = (int)rintf(v[j][1] * inv), q2 = (int)rintf(v[j][2] * inv), q3 = (int)rintf(v[j][3] * inv);
            *((unsigned*)xn + 64 * j + lane) = (unsigned)(q0 & 0xff) | ((unsigned)(q1 & 0xff) << 8) | ((unsigned)(q2 & 0xff) << 16) | ((unsigned)q3 << 24); }
        if (lane == 0) *xn_scale = amax * (1.0f / (127.0f * 127.0f));
    } else {
#pragma unroll
        for (int j = 0; j < 8; ++j) { const f32x4 g = *((const f32x4*)gain + 64 * j + lane);
            if (xn_mode == 1) { *((unsigned*)xn + 64 * j + lane) = pk4_fp8(v[j][0] * rstd * g[0], v[j][1] * rstd * g[1], v[j][2] * rstd * g[2], v[j][3] * rstd * g[3]); }
            else { u32x2 o; o.x = cvt_pk_bf16(v[j][0] * rstd * g[0], v[j][1] * rstd * g[1]); o.y = cvt_pk_bf16(v[j][2] * rstd * g[2], v[j][3] * rstd * g[3]); *((u32x2*)xn + 64 * j + lane) = o; } } }
}
template <bool X_BF16, bool H_BF16>
__device__ __forceinline__ void norm_row(const void* __restrict__ xrow, const void* __restrict__ ya, const void* __restrict__ yb, float w0, float w1,
                                         void* __restrict__ hout, bf16_t* __restrict__ xn, const float* __restrict__ gain, int lane, const int xn_mode  , float* __restrict__ xn_scale) {
    f32x4 v[8]; float s = 0.f;
#pragma unroll
    for (int j = 0; j < 8; ++j) {
        if constexpr (X_BF16) { const u32x2 q = *((const u32x2*)xrow + 64 * j + lane); v[j] = (f32x4){bf_lo(q.x), bf_hi(q.x), bf_lo(q.y), bf_hi(q.y)}; }
        else v[j] = *((const f32x4*)xrow + 64 * j + lane);
        if (ya) {
#if Y_FP8
            const f32x4 a = unpk4_fp8(*((const unsigned*)ya + 64 * j + lane)), b = unpk4_fp8(*((const unsigned*)yb + 64 * j + lane));
            v[j] += w0 * a + w1 * b;
#else
            const u32x2 a = *((const u32x2*)ya + 64 * j + lane), b = *((const u32x2*)yb + 64 * j + lane);
            v[j][0] += w0 * bf_lo(a.x) + w1 * bf_lo(b.x); v[j][1] += w0 * bf_hi(a.x) + w1 * bf_hi(b.x); v[j][2] += w0 * bf_lo(a.y) + w1 * bf_lo(b.y); v[j][3] += w0 * bf_hi(a.y) + w1 * bf_hi(b.y);
#endif
        }
        if constexpr (H_BF16) {
            if (hout) { u32x2 o; o.x = cvt_pk_bf16(v[j][0], v[j][1]); o.y = cvt_pk_bf16(v[j][2], v[j][3]); *((u32x2*)hout + 64 * j + lane) = o; v[j] = (f32x4){bf_lo(o.x), bf_hi(o.x), bf_lo(o.y), bf_hi(o.y)}; } }
        s += (v[j][0] * v[j][0] + v[j][1] * v[j][1]) + (v[j][2] * v[j][2] + v[j][3] * v[j][3]); }
    if constexpr (!H_BF16) { if (hout) {
#pragma unroll
        for (int j = 0; j < 8; ++j) *((f32x4*)hout + 64 * j + lane) = v[j]; } }
    if (xn) {
        const float rstd = 1.0f / sqrtf(wave_sum(s) * (1.f / D) + NORM_EPS);
        if (xn_mode == 2) {
            float amax = 0.f;
#pragma unroll
            for (int j = 0; j < 8; ++j) { const f32x4 g = *((const f32x4*)gain + 64 * j + lane); v[j] = v[j] * rstd * g;
                amax = fmaxf(fmaxf(amax, fmaxf(fabsf(v[j][0]), fabsf(v[j][1]))), fmaxf(fabsf(v[j][2]), fabsf(v[j][3]))); }
#pragma unroll
            for (int o = 1; o < 64; o <<= 1) amax = fmaxf(amax, __shfl_xor(amax, o));
            const float inv = amax > 0.f ? 127.0f / amax : 0.f;
#pragma unroll
            for (int j = 0; j < 8; ++j) { const int q0 = (int)rintf(v[j][0] * inv), q1 = (int)rintf(v[j][1] * inv), q2 = (int)rintf(v[j][2] * inv), q3 = (int)rintf(v[j][3] * inv);
                *((unsigned*)xn + 64 * j + lane) = (unsigned)(q0 & 0xff) | ((unsigned)(q1 & 0xff) << 8) | ((unsigned)(q2 & 0xff) << 16) | ((unsigned)q3 << 24); }
            if (lane == 0) *xn_scale = amax * (1.0f / (127.0f * 127.0f));
        } else {
#pragma unroll
        for (int j = 0; j < 8; ++j) { const f32x4 g = *((const f32x4*)gain + 64 * j + lane);
            if (xn_mode == 1) { *((unsigned*)xn + 64 * j + lane) = pk4_fp8(v[j][0] * rstd * g[0], v[j][1] * rstd * g[1], v[j][2] * rstd * g[2], v[j][3] * rstd * g[3]); }
            else { u32x2 o; o.x = cvt_pk_bf16(v[j][0] * rstd * g[0], v[j][1] * rstd * g[1]); o.y = cvt_pk_bf16(v[j][2] * rstd * g[2], v[j][3] * rstd * g[3]);
                   *((u32x2*)xn + 64 * j + lane) = o; } } } }
}

__device__ __forceinline__ void p0_prologue(Frame& F) {
    const CAS Inputs& I = kargs()->in;
    LAS unsigned* scr = (LAS unsigned*)(F.lds + F.wave * 16384);
    const int gw = F.vcu * NWAVES + F.wave, NGW = F.G * NWAVES;
    unsigned char* ws = F.ws();
    if (INPROJ_MODE == 2) colmax_phase(F);
    { bf16_t* wrt = (bf16_t*)(ws + WS_WRT);
      const int gt = F.vcu * NTHR + F.tid(), NGT = F.G * NTHR;
      for (int i = gt; i < 2 * NRT * D; i += NGT) { const int l = i / (NRT * D), r2 = i % (NRT * D), n = r2 / D, k = r2 % D;
          float w = 0.f; if (n < 8) w = I.moe_w_group[((size_t)l * D + k) * 8 + n]; else if (n < 72) w = I.moe_w_expert[((size_t)l * D + k) * 64 + (n - 8)];
          const _Float16 wh = (_Float16)w;
          wrt[((size_t)(l * 2 + 0) * NRT + n) * D + k] = __builtin_bit_cast(bf16_t, wh); }
      float* rc = (float*)(ws + WS_ROPE); float* rs = rc + (size_t)M * 64;
      for (int i = gt; i < M * 64; i += NGT) { const int t = i >> 6, f = i & 63; const float inv = exp2f(-(float)f * (13.287712379549449f / 64.f)); const float ang = (float)I.positions[t] * inv;
          float rev = ang * 0.15915494309189535f; rev -= rintf(rev);
          rc[i] = __builtin_amdgcn_cosf(rev); rs[i] = __builtin_amdgcn_sinf(rev); }
    }
    { f32x4 xr[8], xnx[8]; const int lane = F.lane();
      if (gw < M) {
#pragma unroll
          for (int j = 0; j < 8; ++j) xr[j] = __builtin_nontemporal_load((const f32x4*)(I.x + (size_t)gw * D) + 64 * j + lane); }
      for (int m = gw; m < M; m += NGW) {
          if (m + NGW < M) {
#pragma unroll
              for (int j = 0; j < 8; ++j) xnx[j] = __builtin_nontemporal_load((const f32x4*)(I.x + (size_t)(m + NGW) * D) + 64 * j + lane); }
          norm_regs(xr, (bf16_t*)(ws + WS_XN + (size_t)m * D * INPROJ_ESZ), I.mix_norm, lane, INPROJ_MODE, (float*)(ws + WS_XNS) + m);
#pragma unroll
          for (int j = 0; j < 8; ++j) xr[j] = xnx[j]; } }
}

constexpr int HG_C = 32;
constexpr int HQ_P = 136, HK_P = 40, HO_P = 132;
constexpr int HL_QD = 0, HL_KI = HL_QD + HG_C * HQ_P * 2, HL_KET = HL_KI + HG_C * HQ_P * 2, HL_VT = HL_KET + 128 * HK_P * 2, HL_DEC = HL_VT + 128 * HK_P * 2, HL_SET = HL_DEC + 512;
constexpr int HL_OT = 2 * HL_SET, HL_OTB = HG_C * HO_P * 4, HL_END = HL_OT + 4 * HL_OTB;
static_assert(HL_END <= RING_BYTES && HL_SET % 16 == 0, "hgrn LDS");
#ifndef HG_REP
#define HG_REP 1
#endif
#ifndef HG_CONV_CUT
#define P0B_CUT 50
#define HG_CONV_CUT 88
#endif
__device__ __forceinline__ bf16x8 pack_acc8(const f32x16& x, int s) {
    u32x4 p; p.x = cvt_pk_bf16(x[8 * s + 0], x[8 * s + 1]); p.y = cvt_pk_bf16(x[8 * s + 2], x[8 * s + 3]); p.z = cvt_pk_bf16(x[8 * s + 4], x[8 * s + 5]); p.w = cvt_pk_bf16(x[8 * s + 6], x[8 * s + 7]);
    return __builtin_bit_cast(bf16x8, p);
}
__device__ __forceinline__ bf16x8 ld2x8(const LAS unsigned char* p0, const LAS unsigned char* p1) {
    const s16x4 a = *(const LAS s16x4*)p0, b = *(const LAS s16x4*)p1; return __builtin_shufflevector(a, b, 0, 1, 2, 3, 4, 5, 6, 7);
}
__device__ __forceinline__ void hgrn_phase(Frame& F) {
    const CAS Inputs& I = kargs()->in;
    LAS unsigned char* L = F.lds;
    const int tid = F.tid(), lane = F.lane(), w = F.wave;
    if (F.vcu & 1) {
        if (P0B_CUT < 100) convert_weights(F, 0, (F.vcu >> 1) * NWAVES + F.wave, (F.G >> 1) * NWAVES, (LAS unsigned*)(F.lds + F.wave * 16384), P0B_CUT, 100);
        convert_weights(F, 1, (F.vcu >> 1) * NWAVES + F.wave, (F.G >> 1) * NWAVES, (LAS unsigned*)(F.lds + F.wave * 16384), 0, HG_CONV_CUT);
        return; }
    const bf16_t* PROJ = (const bf16_t*)(F.ws() + WS_PROJ); bf16_t* MIX = (bf16_t*)(F.ws() + WS_MIX);
    for (int rep2 = 0; rep2 < HG_REP; ++rep2)
    for (int p = F.vcu >> 1; p < BATCH * HG_H; p += (F.G >> 1)) {
        const int b = p / HG_H, h = p % HG_H;
        const int ch = 16 * w + (lane >> 2), seg = lane & 3;
        float lb;
        { const float l0 = I.hgrn_lb[h * 128 + ch], l1 = I.hgrn_lb[D + h * 128 + ch], l2 = I.hgrn_lb[2 * D + h * 128 + ch]; const float mx = fmaxf(l0, fmaxf(l1, l2));
          const float e0 = expf(l0 - mx), e1 = expf(l1 - mx), e2 = expf(l2 - mx); lb = e0 / (e0 + e1 + e2); }
        const float omlb = 1.0f - lb;
        const int vb = w & 3, kh = w >> 2, r = lane & 31, hh = lane >> 5;
        const int c4 = tid >> 4, vs = tid & 15;
        const f32x4 og0 = *(const f32x4*)(I.hgrn_out_gain + 8 * vs), og1 = *(const f32x4*)(I.hgrn_out_gain + 8 * vs + 4);
        f32x16 S0 = {}, S1 = {};
        unsigned rqA[8], rfA[8], rvA[8], rqB[8], rfB[8], rvB[8]; u32x4 rgA, rgB, g_cur, g_next;
        const bf16_t* prow = PROJ + (size_t)(b * SEQ + 8 * seg) * NP0 + h * 128 + ch;
        const bf16_t* grow = PROJ + (size_t)(b * SEQ + c4) * NP0 + 3 * D + h * 128 + 8 * vs;
#define HG_PREFETCH(n_, S) do { const bf16_t* pr_ = prow + (size_t)(n_) * HG_C * NP0; _Pragma("unroll") for (int i = 0; i < 8; ++i) { rq##S[i] = (unsigned)__builtin_nontemporal_load(pr_ + (size_t)i * NP0); rf##S[i] = (unsigned)__builtin_nontemporal_load(pr_ + (size_t)i * NP0 + D); rv##S[i] = (unsigned)__builtin_nontemporal_load(pr_ + (size_t)i * NP0 + 2 * D); } \
        rg##S = __builtin_nontemporal_load((const u32x4*)(grow + (size_t)(n_) * HG_C * NP0)); } while (0)
#define HG_ELEM(T_, S) do { float qv[8], kk[8], cl[8]; float run = 1.f; \
            _Pragma("unroll") for (int i = 0; i < 8; ++i) { qv[i] = __uint_as_float(rq##S[i] << 16); const float e_ = __expf(-__uint_as_float(rf##S[i] << 16)); const float sg_ = __builtin_amdgcn_rcpf(1.0f + e_); \
                kk[i] = omlb * e_ * sg_; run *= lb + omlb * sg_; cl[i] = run; } \
            float pre = 1.f, tot = 1.f; \
            _Pragma("unroll") for (int s2 = 0; s2 < 4; ++s2) { const float sv = __shfl(run, (lane & ~3) + s2); tot *= sv; if (s2 < seg) pre *= sv; } \
            unsigned ke[4], vp[4]; \
            _Pragma("unroll") for (int i = 0; i < 8; i += 2) { const float c0 = pre * cl[i], c1 = pre * cl[i + 1]; const float i0 = __builtin_amdgcn_rcpf(c0), i1 = __builtin_amdgcn_rcpf(c1); \
                ((LAS bf16_t*)((T_) + HL_QD))[(8 * seg + i) * HQ_P + ch] = (bf16_t)(cvt_pk_bf16(qv[i] * c0, 0.f) & 0xffffu); ((LAS bf16_t*)((T_) + HL_QD))[(8 * seg + i + 1) * HQ_P + ch] = (bf16_t)(cvt_pk_bf16(qv[i + 1] * c1, 0.f) & 0xffffu); \
                ((LAS bf16_t*)((T_) + HL_KI))[(8 * seg + i) * HQ_P + ch] = (bf16_t)(cvt_pk_bf16(kk[i] * i0, 0.f) & 0xffffu); ((LAS bf16_t*)((T_) + HL_KI))[(8 * seg + i + 1) * HQ_P + ch] = (bf16_t)(cvt_pk_bf16(kk[i + 1] * i1, 0.f) & 0xffffu); \
                ke[i >> 1] = cvt_pk_bf16(kk[i] * tot * i0, kk[i + 1] * tot * i1); vp[i >> 1] = rv##S[i] | (rv##S[i + 1] << 16); } \
            *(LAS u32x4*)((T_) + HL_KET + (ch * HK_P + 8 * seg) * 2) = (u32x4){ke[0], ke[1], ke[2], ke[3]}; \
            *(LAS u32x4*)((T_) + HL_VT + (ch * HK_P + 8 * seg) * 2) = (u32x4){vp[0], vp[1], vp[2], vp[3]}; \
            if (seg == 0) ((LAS float*)((T_) + HL_DEC))[ch] = tot; } while (0)
        HG_PREFETCH(0, A); HG_PREFETCH(1, B);
        HG_ELEM(L, A); g_cur = rgA;
        HG_PREFETCH(2, A);
        __syncthreads();
#pragma unroll 2
        for (int n = 0; n < SEQ / HG_C; ++n) {
            const int t0 = b * SEQ + n * HG_C;
            LAS unsigned char* T = L + (n & 1) * HL_SET;
            LAS unsigned char* OTn = L + HL_OT + (n & 1) * 2 * HL_OTB;
            f32x16 oacc = {};
            if (kh == 0) {
                f32x16 X = {};
#pragma unroll
                for (int ks = 0; ks < 8; ++ks) { const bf16x8 a = *(const LAS bf16x8*)(T + HL_KI + (r * HQ_P + 16 * ks + 8 * hh) * 2), bq = *(const LAS bf16x8*)(T + HL_QD + (r * HQ_P + 16 * ks + 8 * hh) * 2);
                    X = __builtin_amdgcn_mfma_f32_32x32x16_bf16(a, bq, X, 0, 0, 0); }
#pragma unroll
                for (int i = 0; i < 16; ++i) { const int d = (i & 3) + 8 * (i >> 2) + 4 * hh; if (d > r) X[i] = 0.f; }
#pragma unroll
                for (int s = 0; s < 2; ++s) { const bf16x8 xs = pack_acc8(X, s);
                    const LAS unsigned char* vrow = T + HL_VT + ((32 * vb + r) * HK_P + 16 * s + 4 * hh) * 2;
                    oacc = __builtin_amdgcn_mfma_f32_32x32x16_bf16(xs, ld2x8(vrow, vrow + 16), oacc, 0, 0, 0); }
            }
#pragma unroll
            for (int q2 = 0; q2 < 2; ++q2) { const int kb = 2 * kh + q2;
#pragma unroll
                for (int s = 0; s < 2; ++s) { const bf16x8 xs = pack_acc8(q2 == 0 ? S0 : S1, s);
                    const LAS unsigned char* qrow = T + HL_QD + (r * HQ_P + 32 * kb + 16 * s + 4 * hh) * 2;
                    oacc = __builtin_amdgcn_mfma_f32_32x32x16_bf16(ld2x8(qrow, qrow + 16), xs, oacc, 0, 0, 0); } }
            { LAS float* OTw = (LAS float*)(OTn + kh * HL_OTB);
#pragma unroll
              for (int i = 0; i < 16; ++i) OTw[((i & 3) + 8 * (i >> 2) + 4 * hh) * HO_P + 32 * vb + r] = oacc[i]; }
#pragma unroll
            for (int q2 = 0; q2 < 2; ++q2) { const int kb = 2 * kh + q2; f32x16 Sx = q2 == 0 ? S0 : S1;
#pragma unroll
                for (int i = 0; i < 16; ++i) Sx[i] *= ((LAS float*)(T + HL_DEC))[32 * kb + (i & 3) + 8 * (i >> 2) + 4 * hh];
#pragma unroll
                for (int s = 0; s < 2; ++s) { const bf16x8 a = *(const LAS bf16x8*)(T + HL_KET + ((32 * kb + r) * HK_P + 16 * s + 8 * hh) * 2), bv = *(const LAS bf16x8*)(T + HL_VT + ((32 * vb + r) * HK_P + 16 * s + 8 * hh) * 2);
                    Sx = __builtin_amdgcn_mfma_f32_32x32x16_bf16(a, bv, Sx, 0, 0, 0); }
                if (q2 == 0) S0 = Sx; else S1 = Sx; }
            if (n + 1 < SEQ / HG_C) { LAS unsigned char* Tn = L + ((n + 1) & 1) * HL_SET;
                if ((n + 1) & 1) { HG_ELEM(Tn, B); g_next = rgB; if (n + 3 < SEQ / HG_C) HG_PREFETCH(n + 3, B); }
                else             { HG_ELEM(Tn, A); g_next = rgA; if (n + 3 < SEQ / HG_C) HG_PREFETCH(n + 3, A); } }
            __syncthreads();
            { const LAS float* O0 = (const LAS float*)OTn + c4 * HO_P + 8 * vs; const LAS float* O1 = (const LAS float*)(OTn + HL_OTB) + c4 * HO_P + 8 * vs;
              const f32x4 a = *(const LAS f32x4*)O0 + *(const LAS f32x4*)O1, bq = *(const LAS f32x4*)(O0 + 4) + *(const LAS f32x4*)(O1 + 4);
              float ss = (a[0] * a[0] + a[1] * a[1]) + (a[2] * a[2] + a[3] * a[3]) + (bq[0] * bq[0] + bq[1] * bq[1]) + (bq[2] * bq[2] + bq[3] * bq[3]);
              ss += __shfl_xor(ss, 1); ss += __shfl_xor(ss, 2); ss += __shfl_xor(ss, 4); ss += __shfl_xor(ss, 8);
              const float rstd = 1.0f / sqrtf(ss * (1.f / 128.f) + NORM_EPS);
              const u32x4 gq = g_cur;
              const float y0 = a[0] * rstd * og0[0] * bf_lo(gq.x), y1 = a[1] * rstd * og0[1] * bf_hi(gq.x), y2 = a[2] * rstd * og0[2] * bf_lo(gq.y), y3 = a[3] * rstd * og0[3] * bf_hi(gq.y);
              const float y4 = bq[0] * rstd * og1[0] * bf_lo(gq.z), y5 = bq[1] * rstd * og1[1] * bf_hi(gq.z), y6 = bq[2] * rstd * og1[2] * bf_lo(gq.w), y7 = bq[3] * rstd * og1[3] * bf_hi(gq.w);
#if FP8_OUTPROJ
              u32x2 o; o.x = pk4_fp8(y0, y1, y2, y3); o.y = pk4_fp8(y4, y5, y6, y7);
              *(u32x2*)((unsigned char*)MIX + (size_t)(t0 + c4) * D + h * 128 + 8 * vs) = o; }
#else
              u32x4 o; o.x = cvt_pk_bf16(y0, y1); o.y = cvt_pk_bf16(y2, y3); o.z = cvt_pk_bf16(y4, y5); o.w = cvt_pk_bf16(y6, y7);
              *(u32x4*)(MIX + (size_t)(t0 + c4) * D + h * 128 + 8 * vs) = o; }
#endif
            g_cur = g_next;
        }
#undef HG_PREFETCH
#undef HG_ELEM
        __syncthreads();
    }
    convert_weights(F, 1, (F.vcu >> 1) * NWAVES + F.wave, (F.G >> 1) * NWAVES, (LAS unsigned*)(F.lds + F.wave * 16384), HG_CONV_CUT, 100);
}

constexpr int RL_GN = 0, RL_W = 8192, RW_P = 136, RW_ONE = NRT * RW_P * 2, RL_PL = RL_W, RL_SS = RL_PL + 2 * 4 * 16 * NRT * 4, RL_END = RL_W + 4 * RW_ONE;
static_assert(RL_SS + 2 * 4 * 16 * 4 <= RL_END && RL_END <= RING_BYTES, "router LDS");
__device__ __forceinline__ void router_phase(Frame& F, const bf16_t* __restrict__ Hres, const float* __restrict__ gain, int layer) {
    LAS unsigned char* L = F.lds;
    const int tid = F.tid(), lane = F.lane(), w = F.wave, g = w & 3, kh = w >> 2, r16 = lane & 15, kg = lane >> 4;
    const bf16_t* wrt = (const bf16_t*)(F.ws() + WS_WRT) + (size_t)(layer * 2) * NRT * D;
    bf16_t* XF = (bf16_t*)(F.ws() + WS_XF);
    int* tok_e = (int*)(F.ws() + WS_TOKE); float* tok_w = (float*)(F.ws() + WS_TOKW); int* tok_p = (int*)(F.ws() + WS_TOKP); float* rstd_t = (float*)(F.ws() + WS_RSTDT);
    unsigned* cnt = F.ctl() + CW_CNT + layer * 1024;
    for (int blk = F.vcu; blk < M / 64; blk += F.G) {
        __syncthreads();
        for (int i = tid; i < D / 4; i += NTHR) ((LAS f32x4*)(L + RL_GN))[i] = ((const f32x4*)gain)[i];
        const int t = blk * 64 + 16 * g + r16;
        f32x4 acc[5];
#pragma unroll
        for (int i = 0; i < 5; ++i) acc[i] = (f32x4){0.f, 0.f, 0.f, 0.f};
        float ss = 0.f;
        const bf16_t* hrow = Hres + (size_t)t * D + 1024 * kh + 8 * kg;
        unsigned char* xrow = (unsigned char*)XF + ((size_t)t * D + 1024 * kh + 8 * kg) * (FP8_MOE ? 1 : 2);
        u32x4 wsA[5], wsB[5]; u32x4 haA[4], haB[4], hb[4];
#define RT_WLOAD(b_, S) do { _Pragma("unroll") for (int j = 0; j < 5; ++j) { const int c = tid + 512 * j, kc = c & 15, n = (c >> 4) % NRT, q = (c >> 4) / NRT; \
            ws##S[j] = *(const u32x4*)(wrt + (size_t)n * D + 1024 * q + 128 * (b_) + 8 * kc); } } while (0)
#define RT_WSTORE(S) do { _Pragma("unroll") for (int j = 0; j < 5; ++j) { const int c = tid + 512 * j, kc = c & 15, n = (c >> 4) % NRT, q = (c >> 4) / NRT; \
            *(LAS u32x4*)(L + RL_W + 2 * q * RW_ONE + (n * RW_P + 8 * kc) * 2) = ws##S[j]; } } while (0)
#define RT_ALOAD(b_, S) do { _Pragma("unroll") for (int s = 0; s < 4; ++s) ha##S[s] = *(const u32x4*)(hrow + 128 * (b_) + 32 * s); } while (0)
        RT_WLOAD(0, A); RT_ALOAD(0, A); RT_WLOAD(1, B); RT_ALOAD(1, B);
        for (int b = 0; b < 8; ++b) {
            __syncthreads();
            if (b & 1) { RT_WSTORE(B);
#pragma unroll
                for (int i = 0; i < 4; ++i) hb[i] = haB[i];
                if (b + 2 < 8) { RT_WLOAD(b + 2, B); RT_ALOAD(b + 2, B); } }
            else { RT_WSTORE(A);
#pragma unroll
                for (int i = 0; i < 4; ++i) hb[i] = haA[i];
                if (b + 2 < 8) { RT_WLOAD(b + 2, A); RT_ALOAD(b + 2, A); } }
            __syncthreads();
            const LAS unsigned char* Wh = L + RL_W + (kh * 2 + 0) * RW_ONE + (r16 * RW_P + 8 * kg) * 2;
#pragma unroll
            for (int s = 0; s < 4; ++s) {
                const f32x4 h0 = {bf_lo(hb[s].x), bf_hi(hb[s].x), bf_lo(hb[s].y), bf_hi(hb[s].y)}, h1 = {bf_lo(hb[s].z), bf_hi(hb[s].z), bf_lo(hb[s].w), bf_hi(hb[s].w)};
                const f32x4 g0 = *(const LAS f32x4*)(L + RL_GN + (1024 * kh + 128 * b + 32 * s + 8 * kg) * 4), g1 = *(const LAS f32x4*)(L + RL_GN + (1024 * kh + 128 * b + 32 * s + 8 * kg + 4) * 4);
                ss += (h0[0] * h0[0] + h0[1] * h0[1]) + (h0[2] * h0[2] + h0[3] * h0[3]) + (h1[0] * h1[0] + h1[1] * h1[1]) + (h1[2] * h1[2] + h1[3] * h1[3]);
                const f32x4 x0 = h0 * g0, x1 = h1 * g1;
                const f16x8 ah = {(_Float16)x0[0], (_Float16)x0[1], (_Float16)x0[2], (_Float16)x0[3], (_Float16)x1[0], (_Float16)x1[1], (_Float16)x1[2], (_Float16)x1[3]};
                { u32x2 f8; f8.x = pk4_fp8(x0[0], x0[1], x0[2], x0[3]); f8.y = pk4_fp8(x1[0], x1[1], x1[2], x1[3]); *(u32x2*)(xrow + 128 * b + 32 * s) = f8; }
#pragma unroll
                for (int nt = 0; nt < 5; ++nt) { const f16x8 bh = *(const LAS f16x8*)(Wh + (nt * 16 * RW_P + 32 * s) * 2);
                    acc[nt] = __builtin_amdgcn_mfma_f32_16x16x32_f16(ah, bh, acc[nt], 0, 0, 0); }
            }
        }
#undef RT_WLOAD
#undef RT_WSTORE
#undef RT_ALOAD
        __syncthreads();
        LAS float* PL = (LAS float*)(L + RL_PL) + (size_t)(kh * 4 + g) * 16 * NRT;
#pragma unroll
        for (int nt = 0; nt < 5; ++nt)
#pragma unroll
            for (int i = 0; i < 4; ++i) PL[(4 * kg + i) * NRT + 16 * nt + r16] = acc[nt][i];
        ss += __shfl_xor(ss, 16); ss += __shfl_xor(ss, 32);
        if (lane < 16) ((LAS float*)(L + RL_SS))[(kh * 4 + g) * 16 + lane] = ss;
        __syncthreads();
        if (F.tid() < 64) {
            const int tt = F.tid(), gg = tt >> 4, row = tt & 15, tk = blk * 64 + tt;
            const float s2 = ((LAS float*)(L + RL_SS))[gg * 16 + row] + ((LAS float*)(L + RL_SS))[(4 + gg) * 16 + row];
            const float rstd = 1.0f / sqrtf(s2 * (1.f / D) + NORM_EPS);
            const LAS float* p0 = (LAS float*)(L + RL_PL) + (size_t)(gg * 16 + row) * NRT; const LAS float* p1 = p0 + (size_t)4 * 16 * NRT;
            float gm = -3.0e38f; int gi = 0; float gl[8];
#pragma unroll
            for (int j = 0; j < 8; ++j) { gl[j] = rstd * (p0[j] + p1[j]); if (gl[j] > gm) { gm = gl[j]; gi = j; } }
            float gs = 0.f;
#pragma unroll
            for (int j = 0; j < 8; ++j) gs += expf(gl[j] - gm);
            const float gp = 1.0f / gs;
            float m1 = -3.0e38f, m2 = -3.0e38f; int i1 = 0, i2 = 0;
#pragma unroll
            for (int j = 0; j < 8; ++j) { const float v = rstd * (p0[8 + 8 * gi + j] + p1[8 + 8 * gi + j]);
                if (v > m1) { m2 = m1; i2 = i1; m1 = v; i1 = j; } else if (v > m2) { m2 = v; i2 = j; } }
            const float rr = expf(m2 - m1); const float w1 = gp / (1.0f + rr), w2 = gp * rr / (1.0f + rr);
            const int e1 = gi * 8 + i1, e2 = gi * 8 + i2;
            const int q1 = (int)atomicAdd(cnt + e1 * 16, 1u), q2 = (int)atomicAdd(cnt + e2 * 16, 1u);
            { int2* list = (int2*)(F.ws() + WS_LIST); list[(size_t)e1 * M + q1] = make_int2(tk, __float_as_int(rstd)); list[(size_t)e2 * M + q2] = make_int2(tk, __float_as_int(rstd)); }
            tok_e[2 * tk] = e1; tok_e[2 * tk + 1] = e2; tok_w[2 * tk] = w1; tok_w[2 * tk + 1] = w2; tok_p[2 * tk] = q1; tok_p[2 * tk + 1] = q2; rstd_t[tk] = rstd;
        }
        __syncthreads();
    }
}
__device__ __forceinline__ int moe_tables(Frame& F, int layer) {
    LAS int* est = (LAS int*)(F.lds + TAB_OFF); LAS int* tile_e = est + 72;
    __syncthreads();
    if (F.wave == 0) {
        const int e = F.lane(); const unsigned* cnt = F.ctl() + CW_CNT + layer * 1024;
        const int c = (int)__hip_atomic_load(cnt + e * 16, __ATOMIC_RELAXED, __HIP_MEMORY_SCOPE_AGENT); const int nt = (c + 255) >> 8;
        int incl = nt;
#pragma unroll
        for (int o = 1; o < 64; o <<= 1) { const int v = __shfl_up(incl, o); if (e >= o) incl += v; }
        const int t0 = incl - nt;
        est[e] = t0 << 8; est[72 + 192 + e] = c; if (e == NE - 1) est[NE] = incl << 8;
        for (int k = 0; k < nt; ++k) tile_e[t0 + k] = e; }
    __syncthreads();
    return est[NE] >> 8;
}
__device__ __forceinline__ void scatter_phase(Frame& F, int layer) {
    (void)moe_tables(F, layer);
    const LAS int* est = (const LAS int*)(F.lds + TAB_OFF);
    const int gt = F.vcu * NTHR + F.tid(), NGT = F.G * NTHR;
    const int* tok_e = (const int*)(F.ws() + WS_TOKE); const int* tok_p = (const int*)(F.ws() + WS_TOKP); int* tok_r = (int*)(F.ws() + WS_TOKR); int* row_tok = (int*)(F.ws() + WS_ROWT);
    const float* rstd_t = (const float*)(F.ws() + WS_RSTDT); float* rstd_r = (float*)(F.ws() + WS_RSTDR);
    for (int t = gt; t < M; t += NGT) {
        const int e0 = tok_e[2 * t], e1 = tok_e[2 * t + 1]; const int r0 = est[e0] + tok_p[2 * t], r1 = est[e1] + tok_p[2 * t + 1];
        tok_r[2 * t] = r0; tok_r[2 * t + 1] = r1; row_tok[r0] = t; row_tok[r1] = t; const float rs = rstd_t[t]; rstd_r[r0] = rs; rstd_r[r1] = rs; }
    if (F.vcu < NE) {
        const int e = F.vcu; const unsigned* cnt = F.ctl() + CW_CNT + layer * 1024;
        const int c = (int)__hip_atomic_load(cnt + e * 16, __ATOMIC_RELAXED, __HIP_MEMORY_SCOPE_AGENT);
        for (int r = est[e] + c + F.tid(); r < est[e + 1]; r += NTHR) { row_tok[r] = 0; rstd_r[r] = 0.f; } }
}
struct CombRaw { u32x2 h[8]; u32x2 ya2[8], yb2[8]; unsigned ya[8], yb[8]; };
__device__ __forceinline__ void comb_load(CombRaw& R, const bf16_t* xrow, const unsigned char* ya, const unsigned char* yb, int lane) {
#pragma unroll
    for (int j = 0; j < 8; ++j) { R.h[j] = __builtin_nontemporal_load((const u32x2*)xrow + 64 * j + lane);
#if Y_FP8
        R.ya[j] = __builtin_nontemporal_load((const unsigned*)ya + 64 * j + lane); R.yb[j] = __builtin_nontemporal_load((const unsigned*)yb + 64 * j + lane);
#else
        R.ya2[j] = *((const u32x2*)ya + 64 * j + lane); R.yb2[j] = *((const u32x2*)yb + 64 * j + lane);
#endif
    }
}
template <bool LAST>
__device__ __forceinline__ void comb_finish(const CombRaw& R, float w0, float w1, void* __restrict__ hout, bf16_t* __restrict__ xn, const float* __restrict__ gain, int lane, float* __restrict__ xn_scale) {
    f32x4 v[8]; float s = 0.f;
#pragma unroll
    for (int j = 0; j < 8; ++j) { v[j] = (f32x4){bf_lo(R.h[j].x), bf_hi(R.h[j].x), bf_lo(R.h[j].y), bf_hi(R.h[j].y)};
#if Y_FP8
        v[j] += w0 * unpk4_fp8(R.ya[j]) + w1 * unpk4_fp8(R.yb[j]);
#else
        v[j][0] += w0 * bf_lo(R.ya2[j].x) + w1 * bf_lo(R.yb2[j].x); v[j][1] += w0 * bf_hi(R.ya2[j].x) + w1 * bf_hi(R.yb2[j].x); v[j][2] += w0 * bf_lo(R.ya2[j].y) + w1 * bf_lo(R.yb2[j].y); v[j][3] += w0 * bf_hi(R.ya2[j].y) + w1 * bf_hi(R.yb2[j].y);
#endif
        if constexpr (LAST) __builtin_nontemporal_store(v[j], (f32x4*)hout + 64 * j + lane);
        else { u32x2 o; o.x = cvt_pk_bf16(v[j][0], v[j][1]); o.y = cvt_pk_bf16(v[j][2], v[j][3]); *((u32x2*)hout + 64 * j + lane) = o; v[j] = (f32x4){bf_lo(o.x), bf_hi(o.x), bf_lo(o.y), bf_hi(o.y)};
               s += (v[j][0] * v[j][0] + v[j][1] * v[j][1]) + (v[j][2] * v[j][2] + v[j][3] * v[j][3]); } }
    if constexpr (!LAST) {
        const float rstd = 1.0f / sqrtf(wave_sum(s) * (1.f / D) + NORM_EPS);
        if (INPROJ_MODE == 2) {
            float amax = 0.f;
#pragma unroll
            for (int j = 0; j < 8; ++j) { const f32x4 g = *((const f32x4*)gain + 64 * j + lane); v[j] = v[j] * rstd * g;
                amax = fmaxf(fmaxf(amax, fmaxf(fabsf(v[j][0]), fabsf(v[j][1]))), fmaxf(fabsf(v[j][2]), fabsf(v[j][3]))); }
#pragma unroll
            for (int o = 1; o < 64; o <<= 1) amax = fmaxf(amax, __shfl_xor(amax, o));
            const float inv = amax > 0.f ? 127.0f / amax : 0.f;
#pragma unroll
            for (int j = 0; j < 8; ++j) { const int q0 = (int)rintf(v[j][0] * inv), q1 = (int)rintf(v[j][1] * inv), q2 = (int)rintf(v[j][2] * inv), q3 = (int)rintf(v[j][3] * inv);
                *((unsigned*)xn + 64 * j + lane) = (unsigned)(q0 & 0xff) | ((unsigned)(q1 & 0xff) << 8) | ((unsigned)(q2 & 0xff) << 16) | ((unsigned)q3 << 24); }
            if (lane == 0) *xn_scale = amax * (1.0f / (127.0f * 127.0f));
        } else {
#pragma unroll
            for (int j = 0; j < 8; ++j) { const f32x4 g = *((const f32x4*)gain + 64 * j + lane);
                if (INPROJ_MODE == 1) { *((unsigned*)xn + 64 * j + lane) = pk4_fp8(v[j][0] * rstd * g[0], v[j][1] * rstd * g[1], v[j][2] * rstd * g[2], v[j][3] * rstd * g[3]); }
                else { u32x2 o; o.x = cvt_pk_bf16(v[j][0] * rstd * g[0], v[j][1] * rstd * g[1]); o.y = cvt_pk_bf16(v[j][2] * rstd * g[2], v[j][3] * rstd * g[3]); *((u32x2*)xn + 64 * j + lane) = o; } } } }
}
template <bool LAST>
__device__ __forceinline__ void combine_phase(Frame& F, const bf16_t* __restrict__ hin, void* __restrict__ hout, bf16_t* xn, const float* gain, int layer) {
    (void)moe_tables(F, layer);
    const int gw = F.vcu * NWAVES + F.wave, NGW = F.G * NWAVES, lane = F.lane();
    const int* tok_e = (const int*)(F.ws() + WS_TOKE); const int* tok_p = (const int*)(F.ws() + WS_TOKP); const float* tok_w = (const float*)(F.ws() + WS_TOKW); const unsigned char* Y = (const unsigned char*)(F.ws() + WS_Y);
    const LAS int* est = (const LAS int*)(F.lds + TAB_OFF);
    constexpr size_t YB = (size_t)D * (Y_FP8 ? 1 : 2);
    constexpr int NT_ = M / (256 * NWAVES);
    int r0v[NT_], r1v[NT_]; float w0v[NT_], w1v[NT_];
#pragma unroll
    for (int k = 0; k < NT_; ++k) { const int t = gw + k * NGW; const bool ok = t < M; const int tt = ok ? t : 0;
        r0v[k] = est[tok_e[2 * tt]] + tok_p[2 * tt]; r1v[k] = est[tok_e[2 * tt + 1]] + tok_p[2 * tt + 1]; w0v[k] = tok_w[2 * tt]; w1v[k] = tok_w[2 * tt + 1]; }
    CombRaw RA, RB;
    if (gw < M) comb_load(RA, hin + (size_t)gw * D, Y + (size_t)r0v[0] * YB, Y + (size_t)r1v[0] * YB, lane);
#pragma unroll
    for (int k = 0; k < NT_; ++k) { const int t = gw + k * NGW; if (t >= M) break;
        const int tn = t + NGW; const bool hn = (k + 1 < NT_) && tn < M;
        CombRaw& cur = (k & 1) ? RB : RA; CombRaw& nxt = (k & 1) ? RA : RB;
        if (hn) comb_load(nxt, hin + (size_t)tn * D, Y + (size_t)r0v[k + 1] * YB, Y + (size_t)r1v[k + 1] * YB, lane);
        if constexpr (LAST) comb_finish<true>(cur, w0v[k], w1v[k], (float*)hout + (size_t)t * D, nullptr, gain, lane, nullptr);
        else comb_finish<false>(cur, w0v[k], w1v[k], (bf16_t*)hout + (size_t)t * D, (bf16_t*)((unsigned char*)xn + (size_t)t * D * INPROJ_ESZ), gain, lane, (float*)(F.ws() + WS_XNS) + t);
    }
    if (F.G != 256) {
        for (int t = gw + NT_ * NGW; t < M; t += NGW) { CombRaw R; const int r0 = est[tok_e[2 * t]] + tok_p[2 * t], r1 = est[tok_e[2 * t + 1]] + tok_p[2 * t + 1];
            comb_load(R, hin + (size_t)t * D, Y + (size_t)r0 * YB, Y + (size_t)r1 * YB, lane);
            if constexpr (LAST) comb_finish<true>(R, tok_w[2 * t], tok_w[2 * t + 1], (float*)hout + (size_t)t * D, nullptr, gain, lane, nullptr);
            else comb_finish<false>(R, tok_w[2 * t], tok_w[2 * t + 1], (bf16_t*)hout + (size_t)t * D, (bf16_t*)((unsigned char*)xn + (size_t)t * D * INPROJ_ESZ), gain, lane, (float*)(F.ws() + WS_XNS) + t); } }
}
__device__ __forceinline__ void qknorm_rope_phase(Frame& F) {
    const CAS Inputs& I = kargs()->in;
    const int gw = F.vcu * NWAVES + F.wave, NGW = F.G * NWAVES, l16 = F.lane() & 15, hq = F.lane() >> 4;
    bf16_t* QKV = (bf16_t*)(F.ws() + WS_PROJ); const float* rc = (const float*)(F.ws() + WS_ROPE); const float* rs = rc + (size_t)M * 64;
    for (int t = gw; t < M; t += NGW) {
        const f32x4 cs = *(const f32x4*)(rc + (size_t)t * 64 + 4 * l16), sn = *(const f32x4*)(rs + (size_t)t * 64 + 4 * l16);
#pragma unroll
        for (int it = 0; it < 8; ++it) { const int head = it * 4 + hq;
            bf16_t* p = QKV + (size_t)t * NP1 + head * 128 + 4 * l16;
            const u32x2 a = *(const u32x2*)p, b = *(const u32x2*)(p + 64);
            float x1[4] = {bf_lo(a.x), bf_hi(a.x), bf_lo(a.y), bf_hi(a.y)}, x2[4] = {bf_lo(b.x), bf_hi(b.x), bf_lo(b.y), bf_hi(b.y)};
            float ss = 0.f;
#pragma unroll
            for (int j = 0; j < 4; ++j) ss += x1[j] * x1[j] + x2[j] * x2[j];
            ss += __shfl_xor(ss, 1); ss += __shfl_xor(ss, 2); ss += __shfl_xor(ss, 4); ss += __shfl_xor(ss, 8);
            const float rstd = 1.0f / sqrtf(ss * (1.f / 128.f) + NORM_EPS);
            const float* gn = (head < 16 ? I.diff_q_gain : I.diff_k_gain) + 4 * l16;
            const f32x4 ga = *(const f32x4*)gn, gb = *(const f32x4*)(gn + 64);
            float o1[4], o2[4];
#pragma unroll
            for (int j = 0; j < 4; ++j) { const float y1 = x1[j] * rstd * ga[j], y2 = x2[j] * rstd * gb[j]; o1[j] = y1 * cs[j] - y2 * sn[j]; o2[j] = y2 * cs[j] + y1 * sn[j]; }
            u32x2 oa, ob; oa.x = cvt_pk_bf16(o1[0], o1[1]); oa.y = cvt_pk_bf16(o1[2], o1[3]); ob.x = cvt_pk_bf16(o2[0], o2[1]); ob.y = cvt_pk_bf16(o2[2], o2[3]);
            *(u32x2*)p = oa; *(u32x2*)(p + 64) = ob; }
    }
}
__device__ __forceinline__ att::BlockRef<att::bf16, att::bf16> att_ref(const bf16_t* QKV, bf16_t* ATT, int item, int pass) {
    const int y = item & 3, r = item >> 2, half = r & 1, i = (r >> 1) & 15, b = r >> 5;
    const int qb = pass ? 7 - y : y;
    att::BlockRef<att::bf16, att::bf16> R; const att::bf16* base = (const att::bf16*)QKV + (size_t)b * SEQ * NP1;
    R.Q = base + (size_t)qb * 256 * NP1 + i * 128; R.K = base + D + i * 128; R.V = base + 2 * D + (i >> 1) * 256 + half * 128;
    R.O = (att::bf16*)ATT + ((size_t)b * SEQ + (size_t)qb * 256) * att::OP + i * 256 + half * 128; R.P0 = qb * 256; return R;
}
__device__ __forceinline__ void attention_phase(Frame& F) {
#if ATT_FORM == 2
    const bf16_t* QKV = (const bf16_t*)(F.ws() + WS_PROJ); bf16_t* ATT = (bf16_t*)(F.ws() + WS_ATT);
    extern __shared__ __attribute__((aligned(16))) char att_lds_[]; char* lds = att_lds_;
    float mref;
    { const CAS Inputs& I = kargs()->in; const int lane = F.lane(); float gq = fmaxf(fabsf(I.diff_q_gain[lane]), fabsf(I.diff_q_gain[64 + lane])), gk = fmaxf(fabsf(I.diff_k_gain[lane]), fabsf(I.diff_k_gain[64 + lane]));
#pragma unroll
      for (int o = 1; o < 64; o <<= 1) { gq = fmaxf(gq, __shfl_xor(gq, o)); gk = fmaxf(gk, __shfl_xor(gk, o)); }
      mref = __builtin_amdgcn_readfirstlane(128.0f * 1.02f * gq * gk); }
    constexpr int NITEM = BATCH * 16 * 8;
    for (int item = F.vcu; item < NITEM; item += F.G) {
        const int y = item & 7, i = (item >> 3) & 15, b = item >> 7;
#pragma unroll 1
        for (int pass = 0; pass < 2; ++pass) {
            const int qb = pass ? 15 - y : y;
            const att::bf16* base = (const att::bf16*)QKV + (size_t)b * SEQ * NP1;
            att2::Block B; B.Q = base + (size_t)qb * 128 * NP1 + i * 128; B.K = base + D + i * 128; B.V = base + 2 * D + (i >> 1) * 256;
            B.O = (att::bf16*)ATT + ((size_t)b * SEQ + (size_t)qb * 128) * att2::OP + i * 256; B.P0 = qb * 128;
            att2::block(B, lds, mref);
        }
    }
#else
    const bf16_t* QKV = (const bf16_t*)(F.ws() + WS_PROJ); bf16_t* ATT = (bf16_t*)(F.ws() + WS_ATT);
    constexpr int NITEM = BATCH * 16 * 2 * 4;
    int item = F.vcu, pass = 0; if (item >= NITEM) return;
    extern __shared__ __attribute__((aligned(16))) char att_lds_[]; char* lds = att_lds_;
    att::BlockRef<att::bf16, att::bf16> cur = att_ref(QKV, ATT, item, 0); att::Seam<att::bf16> S;
    att::causal_swa_prime<att::bf16, att::bf16>(cur, SEQ, lds, S);
    for (;;) {
        int itn = item, pn = pass + 1; bool last = false;
        if (pass == 1) { pn = 0; itn = item + F.G; if (itn >= NITEM) { last = true; itn = item; pn = 1; } }
        const att::BlockRef<att::bf16, att::bf16> nxt = last ? cur : att_ref(QKV, ATT, itn, pn);
        att::causal_swa_block<att::bf16, att::bf16>(cur, nxt, SEQ, SEQ, lds, S);
        if (last) break;
        cur = nxt; item = itn; pass = pn;
    }
#endif
}
__device__ __forceinline__ void diffcombine_phase(Frame& F) {
    const CAS Inputs& I = kargs()->in;
    const int gw = F.vcu * NWAVES + F.wave, NGW = F.G * NWAVES, lane = F.lane();
    float lam;
    { const float* lf = I.diff_lambda; const float a0 = lf[lane] * lf[128 + lane] + lf[64 + lane] * lf[128 + 64 + lane], a1 = lf[256 + lane] * lf[384 + lane] + lf[256 + 64 + lane] * lf[384 + 64 + lane];
      lam = expf(wave_sum(a0)) - expf(wave_sum(a1)) + LAMBDA_INIT1; }
    const bf16_t* ATT = (const bf16_t*)(F.ws() + WS_ATT); bf16_t* MIX = (bf16_t*)(F.ws() + WS_MIX);
    const int l32 = lane & 31, hs = lane >> 5;
    const f32x4 g0 = *(const f32x4*)(I.diff_sub_gain + 8 * l32), g1 = *(const f32x4*)(I.diff_sub_gain + 8 * l32 + 4);
    u32x4 ra[4], rb[4], na[4], nb[4];
#define DC_LOAD(t_, a_, b_) do { _Pragma("unroll") for (int it = 0; it < 4; ++it) { const int h = it * 2 + hs; a_[it] = __builtin_nontemporal_load((const u32x4*)(ATT + (size_t)(t_) * 4096 + (2 * h) * 256 + 8 * l32)); b_[it] = __builtin_nontemporal_load((const u32x4*)(ATT + (size_t)(t_) * 4096 + (2 * h + 1) * 256 + 8 * l32)); } } while (0)
    if (gw < M) DC_LOAD(gw, ra, rb);
    for (int t = gw; t < M; t += NGW) {
        float y[4][8]; float amax = 0.f;
        if (t + NGW < M) DC_LOAD(t + NGW, na, nb);
#pragma unroll
        for (int it = 0; it < 4; ++it) { const int h = it * 2 + hs;
            const u32x4 a = ra[it], b = rb[it];
            float o[8] = {bf_lo(a.x) - lam * bf_lo(b.x), bf_hi(a.x) - lam * bf_hi(b.x), bf_lo(a.y) - lam * bf_lo(b.y), bf_hi(a.y) - lam * bf_hi(b.y),
                          bf_lo(a.z) - lam * bf_lo(b.z), bf_hi(a.z) - lam * bf_hi(b.z), bf_lo(a.w) - lam * bf_lo(b.w), bf_hi(a.w) - lam * bf_hi(b.w)};
            float ss = 0.f;
#pragma unroll
            for (int j = 0; j < 8; ++j) ss += o[j] * o[j];
            ss += __shfl_xor(ss, 1); ss += __shfl_xor(ss, 2); ss += __shfl_xor(ss, 4); ss += __shfl_xor(ss, 8); ss += __shfl_xor(ss, 16);
            const float sc = (1.0f - LAMBDA_INIT1) / sqrtf(ss * (1.f / 256.f) + NORM_EPS);
#pragma unroll
            for (int j = 0; j < 8; ++j) { y[it][j] = o[j] * sc * (j < 4 ? g0[j] : g1[j - 4]); amax = fmaxf(amax, fabsf(y[it][j])); } }
#if OUT1_I8
#pragma unroll
        for (int o2 = 1; o2 < 64; o2 <<= 1) amax = fmaxf(amax, __shfl_xor(amax, o2));
        const float inv = amax > 0.f ? 127.0f / amax : 0.f;
#pragma unroll
        for (int it = 0; it < 4; ++it) { const int h = it * 2 + hs; int qv[8];
#pragma unroll
            for (int j = 0; j < 8; ++j) qv[j] = (int)rintf(y[it][j] * inv);
            u32x2 w; w.x = (unsigned)(qv[0] & 0xff) | ((unsigned)(qv[1] & 0xff) << 8) | ((unsigned)(qv[2] & 0xff) << 16) | ((unsigned)qv[3] << 24);
            w.y = (unsigned)(qv[4] & 0xff) | ((unsigned)(qv[5] & 0xff) << 8) | ((unsigned)(qv[6] & 0xff) << 16) | ((unsigned)qv[7] << 24);
            *(u32x2*)((unsigned char*)MIX + (size_t)t * D + h * 256 + 8 * l32) = w; }
        if (lane == 0) ((float*)(F.ws() + WS_XNS))[t] = amax * (1.0f / (127.0f * 127.0f));
#else
#pragma unroll
        for (int it = 0; it < 4; ++it) { const int h = it * 2 + hs;
            u32x4 w; w.x = cvt_pk_bf16(y[it][0], y[it][1]); w.y = cvt_pk_bf16(y[it][2], y[it][3]); w.z = cvt_pk_bf16(y[it][4], y[it][5]); w.w = cvt_pk_bf16(y[it][6], y[it][7]);
            *(u32x4*)(MIX + (size_t)t * D + h * 256 + 8 * l32) = w; }
#endif
#pragma unroll
        for (int it = 0; it < 4; ++it) { ra[it] = na[it]; rb[it] = nb[it]; }
    }
#undef DC_LOAD
}

__global__ void __launch_bounds__(NTHR, 2) trunk_fwd(Args args_unused) {
    extern __shared__ __attribute__((aligned(16))) unsigned char lds[];
#define MK_FRAME() Frame F; F.lds = (LAS unsigned char*)lds; F.wave = __builtin_amdgcn_readfirstlane((int)threadIdx.x >> 6); F.G = gridDim.x; { const int bx = blockIdx.x; F.vcu = (F.G % 8 == 0) ? (bx % 8) * (F.G / 8) + bx / 8 : bx; }
    { MK_FRAME();
      for (int u = F.tid(); u < (LDS_BYTES - LDSCTL_OFF) / 4; u += NTHR) ((LAS unsigned*)(F.lds + LDSCTL_OFF))[u] = 0u;
      __syncthreads();
      if (kargs()->ph_hi - kargs()->ph_lo > 1) (void)xcd_barrier_post(F.ctl() + CW_BAR, (volatile LAS unsigned*)(F.lds + MISC_OFF + 32)); }
#ifndef PH_MASK
#define PH_MASK 0xfff
#endif
#ifndef PH_REPEAT
#define PH_REPEAT 0x0
#endif
#define PH_BEGIN(id) MK_FRAME(); const int lo = kargs()->ph_lo, hi = kargs()->ph_hi; const bool run_ = (STEP_ >= lo && STEP_ < hi) && ((PH_MASK >> (id)) & 1); const int nrep_ = 1 + ((PH_REPEAT >> (id)) & 1)
#define QKF_ (INPROJ_MODE == 2 ? 1 : 0)
#define STEP_OF(id) (layer == 0 ? ((id) == 1 ? 2 : (id) == 2 ? 3 : (id) == 6 ? 4 : (id) == 7 ? 5 : (id) - 9 + 6) \
                                : ((id) == 1 ? 9 : (id) == 3 ? 10 : (id) <= 6 ? (id) + 7 - QKF_ : (id) == 7 ? 14 - QKF_ : (id) - 9 + 15 - QKF_))
#define PH_END() do { if (run_ && STEP_ + 1 < hi) { XcdBarrier bar; bar.bar = F.ctl() + CW_BAR; bar.x = xb_xcc_id(); bar.st = (volatile LAS unsigned*)(F.lds + MISC_OFF + 32); xcd_barrier(bar); } } while (0)

    { constexpr int STEP_ = 0; PH_BEGIN(0); for (int rep_ = 0; run_ && rep_ < nrep_; ++rep_) p0_prologue(F); PH_END(); }
    { constexpr int STEP_ = 1; PH_BEGIN(0); for (int rep_ = 0; run_ && rep_ < nrep_; ++rep_) convert_weights(F, 0, F.vcu * NWAVES + F.wave, F.G * NWAVES, (LAS unsigned*)(F.lds + F.wave * 16384), 0, P0B_CUT); PH_END(); }

    {
        constexpr int layer = 0;
        { constexpr int STEP_ = STEP_OF(1); PH_BEGIN(1); for (int rep_ = 0; run_ && rep_ < nrep_; ++rep_) {
            unsigned char* ws = F.ws();
            constexpr int ESZ = INPROJ_ESZ;
            pg8::DenseOrder S; S.init(ws + WS_XN, ws + (layer == 0 ? WS_WHIN : WS_WDIN), M, layer == 0 ? NP0 : NP1, D * ESZ, F.G, (int)blockIdx.x);
            if constexpr (layer == 0 || INPROJ_MODE != 2) {
                pg8::EpiAct<INPROJ_MODE == 2> E{(bf16_t*)(ws + WS_PROJ), layer == 0 ? NP0 : NP1, layer == 0 ? 0x9u : 0x0u, 8, (const float*)(ws + WS_XNS), (const float*)(F.ctl() + CW_CMAX + (layer == 0 ? CSC_HIN : CSC_DIN))};
                pg8::gemm_phase<pg8::EpiAct<INPROJ_MODE == 2>, pg8::DenseOrder, INPROJ_MODE>(F.lds, D * ESZ, S, E, 127 - WSH_IN);
            } else {
                const CAS Inputs& I = kargs()->in;
                pg8::EpiQKV E{(bf16_t*)(ws + WS_PROJ), NP1, (const float*)(ws + WS_XNS), (const float*)(F.ctl() + CW_CMAX + CSC_DIN), I.diff_q_gain, I.diff_k_gain, (const float*)(ws + WS_ROPE), (const float*)(ws + WS_ROPE) + (size_t)M * 64, (LAS float*)(F.lds + pg8::STAGE_BYTES)};
                pg8::gemm_phase<pg8::EpiQKV, pg8::DenseOrder, INPROJ_MODE>(F.lds, D * ESZ, S, E, 127 - WSH_IN);
            } }
          PH_END(); }
        if (layer == 0) {
            { constexpr int STEP_ = STEP_OF(2); PH_BEGIN(2); for (int rep_ = 0; run_ && rep_ < nrep_; ++rep_) hgrn_phase(F); PH_END(); }
        } else {
            #if INPROJ_MODE != 2
            { constexpr int STEP_ = STEP_OF(3); PH_BEGIN(3); for (int rep_ = 0; run_ && rep_ < nrep_; ++rep_) qknorm_rope_phase(F); PH_END(); }
#endif
            { constexpr int STEP_ = STEP_OF(4); PH_BEGIN(4); for (int rep_ = 0; run_ && rep_ < nrep_; ++rep_) attention_phase(F); PH_END(); }
            { constexpr int STEP_ = STEP_OF(5); PH_BEGIN(5); for (int rep_ = 0; run_ && rep_ < nrep_; ++rep_) diffcombine_phase(F); PH_END(); }
        }
        { constexpr int STEP_ = STEP_OF(6); PH_BEGIN(6); for (int rep_ = 0; run_ && rep_ < nrep_; ++rep_) {
            unsigned char* ws = F.ws();
            const void* hres_in = layer == 0 ? (const void*)kargs()->in.x : (const void*)(ws + WS_H2);
            constexpr bool I8 = OUT1_I8 && layer == 1; constexpr int ESZ = (FP8_OUTPROJ || I8) ? 1 : 2;
            pg8::DenseOrder S; S.init(ws + WS_MIX, ws + (layer == 0 ? WS_WHOUT : WS_WDOUT), M, D, D * ESZ, F.G, (int)blockIdx.x);
            pg8::EpiRes<I8, layer == 0> E{(bf16_t*)(ws + WS_H1), hres_in, D, (const float*)(ws + WS_XNS), (const float*)(F.ctl() + CW_CMAX + CSC_DOUT)};
            pg8::gemm_phase<pg8::EpiRes<I8, layer == 0>, pg8::DenseOrder, I8 ? 2 : (FP8_OUTPROJ ? 1 : 0)>(F.lds, D * ESZ, S, E, 127 - WSH_OUT); }
          PH_END(); }
        { constexpr int STEP_ = STEP_OF(7); PH_BEGIN(7); for (int rep_ = 0; run_ && rep_ < nrep_; ++rep_) router_phase(F, (const bf16_t*)(F.ws() + WS_H1), kargs()->in.ffn_norm + (size_t)layer * D, layer); PH_END(); }
        { constexpr int STEP_ = STEP_OF(9); PH_BEGIN(9); for (int rep_ = 0; run_ && rep_ < nrep_; ++rep_) {
            const int nmt = moe_tables(F, layer);
            unsigned char* ws = F.ws();
            constexpr int ESZ = FP8_MOE ? 1 : 2;
            pg8::GatherOrder S; S.init(ws + WS_XF, ws + WS_WGU + (size_t)layer * NE * 1024 * D * ESZ, nmt, 1024, D * ESZ, F.G, (int)blockIdx.x, (const LAS int*)(F.lds + TAB_OFF) + 72); S.list = (const int2*)(ws + WS_LIST); S.est = (const LAS int*)(F.lds + TAB_OFF); S.cntl = S.est + 72 + 192;
            pg8::EpiSwiglu E{(bf16_t*)(ws + WS_HID), S.list, S.est, S.cntl, FF};
            pg8::gemm_phase<pg8::EpiSwiglu, pg8::GatherOrder, FP8_MOE ? 1 : 0>(F.lds, D * ESZ, S, E, 127 - WSH_GU); }
          PH_END(); }
        { constexpr int STEP_ = STEP_OF(10); PH_BEGIN(10); for (int rep_ = 0; run_ && rep_ < nrep_; ++rep_) {
            const int nmt = moe_tables(F, layer);
            unsigned char* ws = F.ws();
            constexpr int ESZ = FP8_MOE ? 1 : 2;
            pg8::GroupOrder S; S.init(ws + WS_HID, ws + WS_WDN + (size_t)layer * NE * D * FF * ESZ, nmt, D, FF * ESZ, F.G, (int)blockIdx.x, (const LAS int*)(F.lds + TAB_OFF) + 72);
            pg8::EpiAct<false, Y_FP8 != 0> E{(bf16_t*)(ws + WS_Y), D, 0x0u, 8, nullptr, nullptr};
            pg8::gemm_phase<pg8::EpiAct<false, Y_FP8 != 0>, pg8::GroupOrder, FP8_MOE ? 1 : 0>(F.lds, FF * ESZ, S, E, 127 - WSH_DN); }
          PH_END(); }
        { constexpr int STEP_ = STEP_OF(11); PH_BEGIN(11); for (int rep_ = 0; run_ && rep_ < nrep_; ++rep_) {
            unsigned char* ws = F.ws();
            if (layer == 0) combine_phase<false>(F, (const bf16_t*)(ws + WS_H1), ws + WS_H2, (bf16_t*)(ws + WS_XN), kargs()->in.mix_norm + D, layer);
            else combine_phase<true>(F, (const bf16_t*)(ws + WS_H1), kargs()->out, nullptr, nullptr, layer); }
          PH_END(); }
        }
    {
        constexpr int layer = 1;
        { constexpr int STEP_ = STEP_OF(1); PH_BEGIN(1); for (int rep_ = 0; run_ && rep_ < nrep_; ++rep_) {
            unsigned char* ws = F.ws();
            constexpr int ESZ = INPROJ_ESZ;
            pg8::DenseOrder S; S.init(ws + WS_XN, ws + (layer == 0 ? WS_WHIN : WS_WDIN), M, layer == 0 ? NP0 : NP1, D * ESZ, F.G, (int)blockIdx.x);
            if constexpr (layer == 0 || INPROJ_MODE != 2) {
                pg8::EpiAct<INPROJ_MODE == 2> E{(bf16_t*)(ws + WS_PROJ), layer == 0 ? NP0 : NP1, layer == 0 ? 0x9u : 0x0u, 8, (const float*)(ws + WS_XNS), (const float*)(F.ctl() + CW_CMAX + (layer == 0 ? CSC_HIN : CSC_DIN))};
                pg8::gemm_phase<pg8::EpiAct<INPROJ_MODE == 2>, pg8::DenseOrder, INPROJ_MODE>(F.lds, D * ESZ, S, E, 127 - WSH_IN);
            } else {
                const CAS Inputs& I = kargs()->in;
                pg8::EpiQKV E{(bf16_t*)(ws + WS_PROJ), NP1, (const float*)(ws + WS_XNS), (const float*)(F.ctl() + CW_CMAX + CSC_DIN), I.diff_q_gain, I.diff_k_gain, (const float*)(ws + WS_ROPE), (const float*)(ws + WS_ROPE) + (size_t)M * 64, (LAS float*)(F.lds + pg8::STAGE_BYTES)};
                pg8::gemm_phase<pg8::EpiQKV, pg8::DenseOrder, INPROJ_MODE>(F.lds, D * ESZ, S, E, 127 - WSH_IN);
            } }
          PH_END(); }
        if (layer == 0) {
            { constexpr int STEP_ = STEP_OF(2); PH_BEGIN(2); for (int rep_ = 0; run_ && rep_ < nrep_; ++rep_) hgrn_phase(F); PH_END(); }
        } else {
            #if INPROJ_MODE != 2
            { constexpr int STEP_ = STEP_OF(3); PH_BEGIN(3); for (int rep_ = 0; run_ && rep_ < nrep_; ++rep_) qknorm_rope_phase(F); PH_END(); }
#endif
            { constexpr int STEP_ = STEP_OF(4); PH_BEGIN(4); for (int rep_ = 0; run_ && rep_ < nrep_; ++rep_) attention_phase(F); PH_END(); }
            { constexpr int STEP_ = STEP_OF(5); PH_BEGIN(5); for (int rep_ = 0; run_ && rep_ < nrep_; ++rep_) diffcombine_phase(F); PH_END(); }
        }
        { constexpr int STEP_ = STEP_OF(6); PH_BEGIN(6); for (int rep_ = 0; run_ && rep_ < nrep_; ++rep_) {
            unsigned char* ws = F.ws();
            const void* hres_in = layer == 0 ? (const void*)kargs()->in.x : (const void*)(ws + WS_H2);
            constexpr bool I8 = OUT1_I8 && layer == 1; constexpr int ESZ = (FP8_OUTPROJ || I8) ? 1 : 2;
            pg8::DenseOrder S; S.init(ws + WS_MIX, ws + (layer == 0 ? WS_WHOUT : WS_WDOUT), M, D, D * ESZ, F.G, (int)blockIdx.x);
            pg8::EpiRes<I8, layer == 0> E{(bf16_t*)(ws + WS_H1), hres_in, D, (const float*)(ws + WS_XNS), (const float*)(F.ctl() + CW_CMAX + CSC_DOUT)};
            pg8::gemm_phase<pg8::EpiRes<I8, layer == 0>, pg8::DenseOrder, I8 ? 2 : (FP8_OUTPROJ ? 1 : 0)>(F.lds, D * ESZ, S, E, 127 - WSH_OUT); }
          PH_END(); }
        { constexpr int STEP_ = STEP_OF(7); PH_BEGIN(7); for (int rep_ = 0; run_ && rep_ < nrep_; ++rep_) router_phase(F, (const bf16_t*)(F.ws() + WS_H1), kargs()->in.ffn_norm + (size_t)layer * D, layer); PH_END(); }
        { constexpr int STEP_ = STEP_OF(9); PH_BEGIN(9); for (int rep_ = 0; run_ && rep_ < nrep_; ++rep_) {
            const int nmt = moe_tables(F, layer);
            unsigned char* ws = F.ws();
            constexpr int ESZ = FP8_MOE ? 1 : 2;
            pg8::GatherOrder S; S.init(ws + WS_XF, ws + WS_WGU + (size_t)layer * NE * 1024 * D * ESZ, nmt, 1024, D * ESZ, F.G, (int)blockIdx.x, (const LAS int*)(F.lds + TAB_OFF) + 72); S.list = (const int2*)(ws + WS_LIST); S.est = (const LAS int*)(F.lds + TAB_OFF); S.cntl = S.est + 72 + 192;
            pg8::EpiSwiglu E{(bf16_t*)(ws + WS_HID), S.list, S.est, S.cntl, FF};
            pg8::gemm_phase<pg8::EpiSwiglu, pg8::GatherOrder, FP8_MOE ? 1 : 0>(F.lds, D * ESZ, S, E, 127 - WSH_GU); }
          PH_END(); }
        { constexpr int STEP_ = STEP_OF(10); PH_BEGIN(10); for (int rep_ = 0; run_ && rep_ < nrep_; ++rep_) {
            const int nmt = moe_tables(F, layer);
            unsigned char* ws = F.ws();
            constexpr int ESZ = FP8_MOE ? 1 : 2;
            pg8::GroupOrder S; S.init(ws + WS_HID, ws + WS_WDN + (size_t)layer * NE * D * FF * ESZ, nmt, D, FF * ESZ, F.G, (int)blockIdx.x, (const LAS int*)(F.lds + TAB_OFF) + 72);
            pg8::EpiAct<false, Y_FP8 != 0> E{(bf16_t*)(ws + WS_Y), D, 0x0u, 8, nullptr, nullptr};
            pg8::gemm_phase<pg8::EpiAct<false, Y_FP8 != 0>, pg8::GroupOrder, FP8_MOE ? 1 : 0>(F.lds, FF * ESZ, S, E, 127 - WSH_DN); }
          PH_END(); }
        { constexpr int STEP_ = STEP_OF(11); PH_BEGIN(11); for (int rep_ = 0; run_ && rep_ < nrep_; ++rep_) {
            unsigned char* ws = F.ws();
            if (layer == 0) combine_phase<false>(F, (const bf16_t*)(ws + WS_H1), ws + WS_H2, (bf16_t*)(ws + WS_XN), kargs()->in.mix_norm + D, layer);
            else combine_phase<true>(F, (const bf16_t*)(ws + WS_H1), kargs()->out, nullptr, nullptr, layer); }
          PH_END(); }
        }
#undef PH_BEGIN
#undef PH_END
}
constexpr int N_STEPS = 2 + (1 + 1 + 1 + 4) + (1 + 3 + 1 + 4) - (INPROJ_MODE == 2 ? 1 : 0);

extern "C" void kernel_launch(void* const* d_in, const int* in_sizes, int n_in, void* d_out, int out_size, void* d_ws, size_t ws_size, hipStream_t stream) {
    static int grid = 0;
    if (grid == 0) {
        if (n_in != 19 || in_sizes[0] != M * D || out_size != M * D || ws_size < WS_END) { fprintf(stderr, "kernel_launch: shape/workspace mismatch (n_in %d in0 %d out %d ws %zu need %zu)\n", n_in, n_in > 0 ? in_sizes[0] : -1, out_size, ws_size, (size_t)WS_END); grid = -1; return; }
        int dev = 0, cus = 0, per_cu = 0;
        if (hipGetDevice(&dev) != hipSuccess || hipDeviceGetAttribute(&cus, hipDeviceAttributeMultiprocessorCount, dev) != hipSuccess) { grid = -1; return; }
        if (hipFuncSetAttribute((const void*)trunk_fwd, hipFuncAttributeMaxDynamicSharedMemorySize, LDS_BYTES) != hipSuccess) { fprintf(stderr, "kernel_launch: hipFuncSetAttribute failed\n"); grid = -1; return; }
        if (hipOccupancyMaxActiveBlocksPerMultiprocessor(&per_cu, (const void*)trunk_fwd, NTHR, LDS_BYTES) != hipSuccess || per_cu < 1) fprintf(stderr, "kernel_launch: occupancy query reports %d\n", per_cu);
        (void)hipGetLastError();
        grid = cus;
    }
    if (grid < 0) return;
    if (hipMemsetAsync((char*)d_ws + WS_CTL, 0, CTL_ZERO_BYTES, stream) != hipSuccess) return;
    Args a{};
    const void** ip = (const void**)&a.in;
    for (int i = 0; i < 19; ++i) ip[i] = d_in[i];
    a.out = (float*)d_out; a.ws = (unsigned char*)d_ws;
#if MK_ONE_LAUNCH
    a.ph_lo = 0; a.ph_hi = N_STEPS;
    hipLaunchKernelGGL(trunk_fwd, dim3(grid), dim3(NTHR), LDS_BYTES, stream, a);
#else
    for (int s = 0; s < N_STEPS; ++s) { a.ph_lo = s; a.ph_hi = s + 1;
        for (int rep = 0; rep < 1 + ((PROBE_STEPS >> s) & 1); ++rep) hipLaunchKernelGGL(trunk_fwd, dim3(grid), dim3(NTHR), LDS_BYTES, stream, a); }
#endif
}
```

```cpp
#include <hip/hip_runtime.h>
#include <hip/hip_bf16.h>
#include <cstdio>
#include <cstdint>

#ifndef MK_ONE_LAUNCH
#define MK_ONE_LAUNCH 1
#endif
#ifndef PROBE_STEPS
#define PROBE_STEPS 0x0
#endif

#ifndef INPROJ_MODE
#define INPROJ_MODE 2
#endif
#define INPROJ_ESZ (INPROJ_MODE ? 1 : 2)
#ifndef OUT1_I8
#define OUT1_I8 1
#endif
#ifndef OUT0_I8
#define OUT0_I8 1
#endif
#ifndef ATT_FORM
#define ATT_FORM 2
#endif
#ifndef Y_FP8
#define Y_FP8 1
#endif
#ifndef FP8_OUTPROJ
#define FP8_OUTPROJ 0
#endif
#ifndef FP8_MOE
#define FP8_MOE 1
#endif
#define LAS __attribute__((address_space(3)))
#define GAS __attribute__((address_space(1)))
#define CAS __attribute__((address_space(4)))
typedef unsigned short bf16_t;
typedef short bf16x8 __attribute__((ext_vector_type(8)));
typedef _Float16 f16x8 __attribute__((ext_vector_type(8)));
typedef short s16x4 __attribute__((ext_vector_type(4)));
typedef float f32x4 __attribute__((ext_vector_type(4)));
typedef float f32x2 __attribute__((ext_vector_type(2)));
typedef float f32x16 __attribute__((ext_vector_type(16)));
typedef unsigned u32x4 __attribute__((ext_vector_type(4)));
typedef unsigned u32x2 __attribute__((ext_vector_type(2)));
typedef int i32x4 __attribute__((ext_vector_type(4)));
typedef int i32x8 __attribute__((ext_vector_type(8)));

__device__ __forceinline__ unsigned cvt_pk_bf16(float lo, float hi) { unsigned r; asm volatile("v_cvt_pk_bf16_f32 %0, %1, %2" : "=v"(r) : "v"(lo), "v"(hi)); return r; }
__device__ __forceinline__ unsigned pk4_fp8(float a, float b, float c, float d) { int r = 0; r = __builtin_amdgcn_cvt_pk_fp8_f32(a, b, r, false); r = __builtin_amdgcn_cvt_pk_fp8_f32(c, d, r, true); return (unsigned)r; }
__device__ __forceinline__ f32x4 unpk4_fp8(unsigned w) { const f32x2 a = __builtin_amdgcn_cvt_pk_f32_fp8((int)w, false), b = __builtin_amdgcn_cvt_pk_f32_fp8((int)w, true); return (f32x4){a[0], a[1], b[0], b[1]}; }
constexpr int WSH_IN = 6, WSH_OUT = 6, WSH_GU = 6, WSH_DN = 5;
__device__ __forceinline__ float bf_lo(unsigned w) { return __uint_as_float(w << 16); }
__device__ __forceinline__ float bf_hi(unsigned w) { return __uint_as_float(w & 0xffff0000u); }
__device__ __forceinline__ float bf2f(bf16_t b) { return __uint_as_float(((unsigned)b) << 16); }
__device__ __forceinline__ float fast_exp(float x) { return __builtin_amdgcn_exp2f(x * 1.4426950408889634f); }
__device__ __forceinline__ float silu_f(float x) { return x * __builtin_amdgcn_rcpf(1.0f + fast_exp(-x)); }

constexpr int NWAVES = 8, NTHR = 512;
constexpr int BATCH = 8, SEQ = 2048, D = 2048, M = BATCH * SEQ;
constexpr int HG_H = 16, HG_K = 128;
constexpr int DA_H = 8, DA_HD = 128;
constexpr int NE = 64, FF = 512, NRT = 80;
constexpr int NP0 = 4 * D, NP1 = 6 * DA_H * DA_HD;
constexpr int RMAX = 2 * M + NE * 256;
constexpr float NORM_EPS = 1e-6f;
constexpr float LAMBDA_INIT1 = 0.35550906f;

constexpr size_t MiB = 1u << 20;
constexpr size_t WS_CTL = 0, CTL_ZERO_BYTES = 160 * 1024;
constexpr size_t WS_TOKE = 1 * MiB;
constexpr size_t WS_TOKW = WS_TOKE + (size_t)M * 8;
constexpr size_t WS_TOKP = WS_TOKW + (size_t)M * 8;
constexpr size_t WS_TOKR = WS_TOKP + (size_t)M * 8;
constexpr size_t WS_RSTDT = WS_TOKR + (size_t)M * 8;
constexpr size_t WS_RSTDR = WS_RSTDT + (size_t)M * 4;
constexpr size_t WS_ROWT = WS_RSTDR + (size_t)RMAX * 4;
constexpr size_t WS_XNS = WS_ROWT + (size_t)RMAX * 4;
constexpr size_t WS_WRT = 2 * MiB;
constexpr size_t WS_ROPE = 4 * MiB;
constexpr size_t WS_WHIN = 16 * MiB;
constexpr size_t WS_WHOUT = WS_WHIN + 32 * MiB;
constexpr size_t WS_WDIN = WS_WHOUT + 8 * MiB;
constexpr size_t WS_WDOUT = WS_WDIN + 24 * MiB;
constexpr size_t WS_WGU = WS_WDOUT + 8 * MiB;
constexpr size_t WS_WDN = WS_WGU + 512 * MiB;
constexpr size_t WS_XN = WS_WDN + 256 * MiB;
constexpr size_t WS_PROJ = WS_XN + 64 * MiB;
constexpr size_t WS_MIX = WS_PROJ + 256 * MiB;
constexpr size_t WS_H1 = WS_MIX + 64 * MiB;
constexpr size_t WS_XF = WS_H1 + 128 * MiB;
constexpr size_t WS_XP = WS_XF + 64 * MiB;
constexpr size_t WS_HID = WS_XP + 192 * MiB;
constexpr size_t WS_Y = WS_HID + 48 * MiB;
constexpr size_t WS_H2 = WS_Y + 192 * MiB;
constexpr size_t WS_END = WS_H2 + 128 * MiB;
constexpr size_t WS_XB = WS_XP + 128 * MiB;
constexpr size_t WS_ATT = WS_XP;
constexpr size_t WS_LIST = WS_HID + 40 * MiB;
static_assert(WS_END <= 2048 * MiB, "d_ws map");
static_assert(WS_XNS + (size_t)M * 4 <= WS_WRT, "small tables");
constexpr int CW_TMO = 0, CW_CODE = 1;
constexpr int CW_BAR = 4096;
constexpr int CW_CMAX = 16384;   static_assert((16384 + 8192 + 2048 + 6144 + 2048) * 4 <= 160 * 1024, "control words inside the per-call memset");
constexpr int CSC_HIN = 0, CSC_HOUT = NP0, CSC_DIN = NP0 + D, CSC_DOUT = NP0 + D + NP1;
constexpr int CW_QUEUE = 12288;
constexpr int CW_CNT = 8192;

constexpr int RING_BYTES = 147456;
constexpr int LDSCTL_OFF = RING_BYTES, MISC_OFF = LDSCTL_OFF + 320;
constexpr int TAB_OFF = MISC_OFF + 128;
constexpr int LDS_BYTES = RING_BYTES + 2048;
static_assert(TAB_OFF + (72 + 192 + 64) * 4 <= LDS_BYTES, "LDS map");

namespace pg8 {
constexpr int BM = 256, BK = 64, HALF = 128, HTB = HALF * BK * 2, STAGE_BYTES = 8 * HTB, NXCD = 8, WGM = 4;
__host__ __device__ __forceinline__ int lds_byte(int r, int c) { const int st = (r >> 4) * 2 + (c >> 5), rr = r & 15, cc = c & 31, ob = rr * 64 + cc * 2; return st * 1024 + (ob ^ (((ob >> 9) & 1) << 5)); }
__host__ __device__ __forceinline__ void stage_rc(int b, int& R, int& C) { const int st = b / 1024, sb = b % 1024, swz = sb ^ (((sb >> 9) & 1) << 5); R = (st >> 1) * 16 + swz / 64; C = (st & 1) * 32 + (swz % 64) / 2; }
__host__ __device__ __forceinline__ int perm32(int rho) { const int n = rho >> 4, i = rho & 15; return 8 * (i >> 2) + 4 * n + (i & 3); }

struct Unit { int pm, pn, aux; const char* A; const char* B; };

__device__ __forceinline__ int remap_id(int L, int nwg) { const int q = nwg / NXCD, r = nwg % NXCD, xcd = L % NXCD, off = L / NXCD; return (xcd < r ? xcd * (q + 1) : r * (q + 1) + (xcd - r) * q) + off; }

struct DenseOrder {
    static constexpr bool GATHER = false; const int2* list = nullptr; const LAS int* est = nullptr; const LAS int* cntl = nullptr;
    int nM, nN, nwg, G, c; const char* A; const char* B; size_t tstep;
    __device__ void init(const void* A_, const void* Bt_, int Mr, int N, int rowbytes, int G_, int c_) { nM = Mr / BM; nN = N / BM; nwg = nM * nN; G = G_; c = c_; A = (const char*)A_; B = (const char*)Bt_; tstep = (size_t)BM * rowbytes; }
    __device__ __forceinline__ bool next(int i, Unit& u) const {
        const long L = (long)i * G + c; if (L >= nwg) return false;
        const int wgid = remap_id((int)L, nwg);
        const int nig = WGM * nN, gid = wgid / nig, fm = gid * WGM, gsz = (nM - fm) < WGM ? (nM - fm) : WGM;
        u.pm = fm + ((wgid % nig) % gsz); u.pn = (wgid % nig) / gsz; u.aux = 0;
        u.A = A + (size_t)u.pm * tstep; u.B = B + (size_t)u.pn * tstep; return true;
    }
};
template <bool GATHER_> struct GroupOrderT {
    static constexpr bool GATHER = GATHER_; const int2* list = nullptr; const LAS int* est = nullptr; const LAS int* cntl = nullptr;
    int nM, nN, nwg, G, c; const char* A; const char* B; size_t tstepA, tstepB; const LAS int* tile_e;
    __device__ void init(const void* A_, const void* Bt_, int nM_, int N, int rowbytes, int G_, int c_, const LAS int* te) { nM = nM_; nN = N / BM; nwg = nM * nN; G = G_; c = c_; A = (const char*)A_; B = (const char*)Bt_; tstepA = (size_t)BM * rowbytes; tstepB = tstepA; tile_e = te; }
    __device__ __forceinline__ bool next(int i, Unit& u) const {
        const long L = (long)i * G + c; if (L >= nwg) return false;
        const int wgid = remap_id((int)L, nwg);
        u.pm = wgid / nN; u.pn = wgid % nN; const int e = __builtin_amdgcn_readfirstlane(tile_e[u.pm]); u.aux = e;
        u.A = GATHER ? A : A + (size_t)u.pm * tstepA; u.B = B + ((size_t)e * nN + u.pn) * tstepB; return true;
    }
};
typedef GroupOrderT<false> GroupOrder;
typedef GroupOrderT<true> GatherOrder;

template <bool DEQ, bool OUT8 = false> struct EpiAct {
    static_assert(!(DEQ && OUT8), "EpiAct");
    static constexpr bool PERM = true; static __host__ __device__ __forceinline__ int brow(int R) {
        if constexpr (OUT8) { return 64 * ((R >> 5) & 3) + 16 * ((R >> 2) & 3) + 4 * ((R >> 4) & 1) + (R & 3); } else return (R & ~31) + perm32(R & 31); }
    static constexpr int BSTEP = OUT8 ? 8 : HALF;
    bf16_t* O; int ldc; unsigned silu_mask; int seg_tiles; const float* sa; const float* sb;
    __device__ __forceinline__ void operator()(const f32x4 (&acc)[2][2][4][2], const Unit& u, int wr, int wc, int fr, int fq) const {
        const int row0 = u.pm * BM + wr * 64 + fr; const int col0 = u.pn * BM + wc * 32 + 8 * fq;
        const bool act = (silu_mask >> (u.pn / seg_tiles)) & 1u;
        f32x4 cs[2][2];
        if constexpr (DEQ) {
#pragma unroll
            for (int bj = 0; bj < 2; ++bj) { cs[bj][0] = *(const f32x4*)(sb + col0 + bj * HALF); cs[bj][1] = *(const f32x4*)(sb + col0 + bj * HALF + 4); } }
        float rsv[2][4];
#pragma unroll
        for (int ai = 0; ai < 2; ++ai)
#pragma unroll
            for (int m = 0; m < 4; ++m) { rsv[ai][m] = 1.f; if constexpr (DEQ) rsv[ai][m] = sa[row0 + ai * HALF + m * 16]; }
#pragma unroll
        for (int ai = 0; ai < 2; ++ai)
#pragma unroll
            for (int m = 0; m < 4; ++m) { bf16_t* rowp = O + (size_t)(row0 + ai * HALF + m * 16) * ldc + col0;
                const float rsc = rsv[ai][m]; u32x4 w8;
#pragma unroll
                for (int bj = 0; bj < 2; ++bj) { f32x4 v0 = acc[ai][bj][m][0], v1 = acc[ai][bj][m][1];
                    if constexpr (DEQ) {
#pragma unroll
                        for (int j = 0; j < 4; ++j) { v0[j] = (float)__float_as_int(v0[j]) * rsc * cs[bj][0][j]; v1[j] = (float)__float_as_int(v1[j]) * rsc * cs[bj][1][j]; } }
                    if (act) {
#pragma unroll
                        for (int j = 0; j < 4; ++j) { v0[j] = silu_f(v0[j]); v1[j] = silu_f(v1[j]); } }
                    if constexpr (OUT8) { const unsigned a_ = pk4_fp8(v0[0], v0[1], v0[2], v0[3]), b_ = pk4_fp8(v1[0], v1[1], v1[2], v1[3]); if (bj == 0) { w8.x = a_; w8.y = b_; } else { w8.z = a_; w8.w = b_; }
                        if (bj == 1) *(u32x4*)((unsigned char*)O + (size_t)(row0 + ai * HALF + m * 16) * ldc + u.pn * BM + wc * 64 + 16 * fq) = w8; }
                    else { u32x4 w; w.x = cvt_pk_bf16(v0[0], v0[1]); w.y = cvt_pk_bf16(v0[2], v0[3]); w.z = cvt_pk_bf16(v1[0], v1[1]); w.w = cvt_pk_bf16(v1[2], v1[3]);
                        *(u32x4*)(rowp + bj * HALF) = w; } } }
    }
};
template <bool DEQ, bool RES_F32> struct EpiRes {
    static constexpr bool PERM = true; static constexpr int BSTEP = HALF; static __host__ __device__ __forceinline__ int brow(int R) { return (R & ~31) + perm32(R & 31); }
    bf16_t* C; const void* res; int ldc; const float* sa; const float* sb;
    __device__ __forceinline__ void operator()(const f32x4 (&acc)[2][2][4][2], const Unit& u, int wr, int wc, int fr, int fq) const {
        const int row0 = u.pm * BM + wr * 64 + fr, col0 = u.pn * BM + wc * 32 + 8 * fq;
        u32x4 q[4][2], w0[4][2]; f32x4 qf[4][2][2]; f32x4 cs[2][2]; float rsv[2][4];
        if constexpr (DEQ) {
#pragma unroll
            for (int bj = 0; bj < 2; ++bj) { cs[bj][0] = *(const f32x4*)(sb + col0 + bj * HALF); cs[bj][1] = *(const f32x4*)(sb + col0 + bj * HALF + 4); }
#pragma unroll
            for (int ai = 0; ai < 2; ++ai)
#pragma unroll
                for (int m = 0; m < 4; ++m) rsv[ai][m] = sa[row0 + ai * HALF + m * 16]; }
#define ER_LOAD(ai) do { _Pragma("unroll") for (int m = 0; m < 4; ++m) _Pragma("unroll") for (int bj = 0; bj < 2; ++bj) { const size_t ro_ = (size_t)(row0 + (ai) * HALF + m * 16) * ldc + col0 + bj * HALF; \
            if constexpr (RES_F32) { qf[m][bj][0] = *(const f32x4*)((const float*)res + ro_); qf[m][bj][1] = *(const f32x4*)((const float*)res + ro_ + 4); } else q[m][bj] = *(const u32x4*)((const bf16_t*)res + ro_); } } while (0)
#define ER_CALC(ai, m, bj, w_) do { f32x4 a0 = acc[ai][bj][m][0], a1 = acc[ai][bj][m][1]; f32x4 r0_, r1_; \
            if constexpr (RES_F32) { r0_ = qf[m][bj][0]; r1_ = qf[m][bj][1]; } else { const u32x4 r = q[m][bj]; r0_ = (f32x4){bf_lo(r.x), bf_hi(r.x), bf_lo(r.y), bf_hi(r.y)}; r1_ = (f32x4){bf_lo(r.z), bf_hi(r.z), bf_lo(r.w), bf_hi(r.w)}; } \
            if constexpr (DEQ) { _Pragma("unroll") for (int j = 0; j < 4; ++j) { a0[j] = (float)__float_as_int(a0[j]) * rsv[ai][m] * cs[bj][0][j]; a1[j] = (float)__float_as_int(a1[j]) * rsv[ai][m] * cs[bj][1][j]; } } \
            const f32x4 v0 = a0 + r0_, v1 = a1 + r1_; \
            w_.x = cvt_pk_bf16(v0[0], v0[1]); w_.y = cvt_pk_bf16(v0[2], v0[3]); w_.z = cvt_pk_bf16(v1[0], v1[1]); w_.w = cvt_pk_bf16(v1[2], v1[3]); } while (0)
        ER_LOAD(0);
#pragma unroll
        for (int m = 0; m < 4; ++m)
#pragma unroll
            for (int bj = 0; bj < 2; ++bj) ER_CALC(0, m, bj, w0[m][bj]);
        asm volatile("" ::: "memory");
        ER_LOAD(1);
        asm volatile("" ::: "memory");
#pragma unroll
        for (int m = 0; m < 4; ++m)
#pragma unroll
            for (int bj = 0; bj < 2; ++bj) *(u32x4*)(C + (size_t)(row0 + m * 16) * ldc + col0 + bj * HALF) = w0[m][bj];
#pragma unroll
        for (int m = 0; m < 4; ++m)
#pragma unroll
            for (int bj = 0; bj < 2; ++bj) { u32x4 w; ER_CALC(1, m, bj, w); *(u32x4*)(C + (size_t)(row0 + HALF + m * 16) * ldc + col0 + bj * HALF) = w; }
#undef ER_LOAD
#undef ER_CALC
    }
};
struct EpiQKV {
    static constexpr bool PERM = true; static constexpr int BSTEP = HALF; static __host__ __device__ __forceinline__ int brow(int R) { return ((R >> 4) & 1) * 64 + (R >> 5) * 16 + (R & 15); }
    bf16_t* O; int ldc; const float* sa; const float* sb; const float* qg; const float* kg; const float* rc; const float* rs; LAS float* X;
    __device__ __forceinline__ void operator()(const f32x4 (&acc)[2][2][4][2], const Unit& u, int wr, int wc, int fr, int fq) const {
        const int row0 = u.pm * BM + wr * 64 + fr, lrow0 = wr * 64 + fr; const int cl = 16 * wc + 4 * fq;
        const bool qk = u.pn < 16;
        f32x4 cs[2][2]; float rsv[2][4];
#pragma unroll
        for (int bj = 0; bj < 2; ++bj)
#pragma unroll
            for (int n = 0; n < 2; ++n) cs[bj][n] = *(const f32x4*)(sb + u.pn * BM + bj * HALF + 64 * n + cl);
#pragma unroll
        for (int ai = 0; ai < 2; ++ai)
#pragma unroll
            for (int m = 0; m < 4; ++m) rsv[ai][m] = sa[row0 + ai * HALF + m * 16];
#define QKV_DEQ(ai, m, bj, n) ((f32x4){(float)__float_as_int(acc[ai][bj][m][n][0]), (float)__float_as_int(acc[ai][bj][m][n][1]), (float)__float_as_int(acc[ai][bj][m][n][2]), (float)__float_as_int(acc[ai][bj][m][n][3])} * rsv[ai][m] * cs[bj][n])
        if (!qk) {
#pragma unroll
            for (int ai = 0; ai < 2; ++ai)
#pragma unroll
                for (int m = 0; m < 4; ++m) { bf16_t* rowp = O + (size_t)(row0 + ai * HALF + m * 16) * ldc + u.pn * BM + cl;
#pragma unroll
                    for (int bj = 0; bj < 2; ++bj)
#pragma unroll
                        for (int n = 0; n < 2; ++n) { const f32x4 v = QKV_DEQ(ai, m, bj, n); u32x2 w; w.x = cvt_pk_bf16(v[0], v[1]); w.y = cvt_pk_bf16(v[2], v[3]); *(u32x2*)(rowp + bj * HALF + 64 * n) = w; } }
            return; }
        const float* gn = (u.pn < 8 ? qg : kg) + cl;
        const f32x4 g0 = *(const f32x4*)gn, g1 = *(const f32x4*)(gn + 64);
        f32x4 cv[2][4], sv[2][4];
#define QKV_LDCS(ai) do { _Pragma("unroll") for (int m = 0; m < 4; ++m) { const size_t ro = (size_t)(row0 + (ai) * HALF + m * 16) * 64 + cl; cv[ai][m] = *(const f32x4*)(rc + ro); sv[ai][m] = *(const f32x4*)(rs + ro); } } while (0)
        QKV_LDCS(0); asm volatile("" ::: "memory");
#pragma unroll
        for (int ai = 0; ai < 2; ++ai)
#pragma unroll
            for (int m = 0; m < 4; ++m)
#pragma unroll
                for (int bj = 0; bj < 2; ++bj) { const f32x4 a = QKV_DEQ(ai, m, bj, 0), b = QKV_DEQ(ai, m, bj, 1);
                    float ss = (a[0] * a[0] + a[1] * a[1]) + (a[2] * a[2] + a[3] * a[3]) + (b[0] * b[0] + b[1] * b[1]) + (b[2] * b[2] + b[3] * b[3]);
                    ss += __shfl_xor(ss, 16); ss += __shfl_xor(ss, 32);
                    if (fq == 0) X[((ai * HALF + lrow0 + m * 16) * 2 + bj) * 4 + wc] = ss; }
        asm volatile("s_waitcnt lgkmcnt(0)" ::: "memory"); __builtin_amdgcn_s_barrier(); asm volatile("" ::: "memory");
        QKV_LDCS(1); asm volatile("" ::: "memory");
#undef QKV_LDCS
#pragma unroll
        for (int ai = 0; ai < 2; ++ai)
#pragma unroll
            for (int m = 0; m < 4; ++m) { bf16_t* rowp = O + (size_t)(row0 + ai * HALF + m * 16) * ldc + u.pn * BM + cl;
#pragma unroll
                for (int bj = 0; bj < 2; ++bj) { const f32x4 p = *(const LAS f32x4*)(X + ((ai * HALF + lrow0 + m * 16) * 2 + bj) * 4);
                    const float rstd = 1.0f / sqrtf(((p[0] + p[1]) + (p[2] + p[3])) * (1.f / 128.f) + NORM_EPS);
                    const f32x4 y1 = QKV_DEQ(ai, m, bj, 0) * rstd * g0, y2 = QKV_DEQ(ai, m, bj, 1) * rstd * g1;
                    const f32x4 o1 = y1 * cv[ai][m] - y2 * sv[ai][m], o2 = y2 * cv[ai][m] + y1 * sv[ai][m];
                    u32x2 w1, w2; w1.x = cvt_pk_bf16(o1[0], o1[1]); w1.y = cvt_pk_bf16(o1[2], o1[3]); w2.x = cvt_pk_bf16(o2[0], o2[1]); w2.y = cvt_pk_bf16(o2[2], o2[3]);
                    *(u32x2*)(rowp + bj * HALF) = w1; *(u32x2*)(rowp + bj * HALF + 64) = w2; } }
#undef QKV_DEQ
    }
};
struct EpiF32Res {
    static constexpr bool PERM = false; static constexpr int BSTEP = HALF; static __host__ __device__ __forceinline__ int brow(int R) { return R; }
    float* C; const float* res; int ldc;
    __device__ __forceinline__ void operator()(const f32x4 (&acc)[2][2][4][2], const Unit& u, int wr, int wc, int fr, int fq) const {
        const int row0 = u.pm * BM + wr * 64 + fr, col0 = u.pn * BM + wc * 32 + 4 * fq;
#pragma unroll
        for (int ai = 0; ai < 2; ++ai)
#pragma unroll
            for (int m = 0; m < 4; ++m) { const size_t off = (size_t)(row0 + ai * HALF + m * 16) * ldc + col0;
                f32x4 rv[2][2];
#pragma unroll
                for (int bj = 0; bj < 2; ++bj)
#pragma unroll
                    for (int n = 0; n < 2; ++n) rv[bj][n] = *(const f32x4*)(res + off + bj * HALF + n * 16);
#pragma unroll
                for (int bj = 0; bj < 2; ++bj)
#pragma unroll
                    for (int n = 0; n < 2; ++n) *(f32x4*)(C + off + bj * HALF + n * 16) = acc[ai][bj][m][n] + rv[bj][n]; }
    }
};
struct EpiSwiglu {
    static constexpr bool PERM = true; static constexpr int BSTEP = HALF; static __host__ __device__ __forceinline__ int brow(int R) { return (R & ~31) + perm32(R & 31); }
    bf16_t* H; const int2* list; const LAS int* est; const LAS int* cntl; int ldc;
    __device__ __forceinline__ void operator()(const f32x4 (&acc)[2][2][4][2], const Unit& u, int wr, int wc, int fr, int fq) const {
        const int row0 = u.pm * BM + wr * 64 + fr; const int col0 = u.pn * HALF + wc * 32 + 8 * fq;
        float rsv[2][4];
#pragma unroll
        for (int ai = 0; ai < 2; ++ai)
#pragma unroll
            for (int m = 0; m < 4; ++m) { const int lr = row0 + ai * HALF + m * 16 - est[u.aux]; rsv[ai][m] = lr < cntl[u.aux] ? __int_as_float(list[(size_t)u.aux * M + lr].y) : 0.f; }
#pragma unroll
        for (int ai = 0; ai < 2; ++ai)
#pragma unroll
            for (int m = 0; m < 4; ++m) { const int row = row0 + ai * HALF + m * 16; const float rs = rsv[ai][m];
                f32x4 h0, h1;
#pragma unroll
                for (int j = 0; j < 4; ++j) { h0[j] = silu_f(acc[ai][0][m][0][j] * rs) * (acc[ai][1][m][0][j] * rs); h1[j] = silu_f(acc[ai][0][m][1][j] * rs) * (acc[ai][1][m][1][j] * rs); }
#if FP8_MOE
                u32x2 w; w.x = pk4_fp8(h0[0], h0[1], h0[2], h0[3]); w.y = pk4_fp8(h1[0], h1[1], h1[2], h1[3]);
                *(u32x2*)((unsigned char*)H + (size_t)row * ldc + col0) = w; }
#else
                u32x4 w; w.x = cvt_pk_bf16(h0[0], h0[1]); w.y = cvt_pk_bf16(h0[2], h0[3]); w.z = cvt_pk_bf16(h1[0], h1[1]); w.w = cvt_pk_bf16(h1[2], h1[3]);
                *(u32x4*)(H + (size_t)row * ldc + col0) = w; }
#endif
    }
};

template <class Epi, class Sched, int MODE>
__device__ __forceinline__ void gemm_phase(LAS unsigned char* lds, const int RB, const Sched& S, const Epi& E, const int wsc) {
    const int tid = threadIdx.x, wid = __builtin_amdgcn_readfirstlane(tid >> 6), lane = tid & 63, wr = wid >> 2, wc = wid & 3, fr = lane & 15, fq = lane >> 4;
    const int nt = RB / (BK * 2);
    unsigned voffA[2], voffB[2];
#pragma unroll
    for (int i = 0; i < 2; ++i) { int R, C; stage_rc(tid * 16 + i * 8192, R, C); const int Rb = Epi::brow(R);
        voffA[i] = (unsigned)(R * RB + C * 2); voffB[i] = (unsigned)(Rb * RB + C * 2); }
    const size_t kstep = (size_t)(BK * 2);
    const size_t hstep = (size_t)HALF * RB;
    const size_t hstepB = (size_t)Epi::BSTEP * RB;
    const int wscale = wsc * 0x01010101, ascale = 0x7f7f7f7f;
    constexpr bool GATHER = Sched::GATHER;
    unsigned cvo[2][2] = {{0u, 0u}, {0u, 0u}}, nvo[2][2] = {{0u, 0u}, {0u, 0u}};
    int gR[2], gC[2];
#pragma unroll
    for (int i = 0; i < 2; ++i) { stage_rc(tid * 16 + i * 8192, gR[i], gC[i]); }
#define PG8_GTOK(u_, o_) do { const int e_ = (u_).aux, lb_ = (u_).pm * BM - S.est[e_], c_ = S.cntl[e_]; _Pragma("unroll") for (int h_ = 0; h_ < 2; ++h_) _Pragma("unroll") for (int i_ = 0; i_ < 2; ++i_) { const int lr_ = lb_ + h_ * HALF + gR[i_]; \
        o_[h_][i_] = lr_ < c_ ? (unsigned)S.list[(size_t)e_ * M + lr_].x : 0u; } } while (0)
#define PG8_GOFF(o_) do { _Pragma("unroll") for (int h_ = 0; h_ < 2; ++h_) _Pragma("unroll") for (int i_ = 0; i_ < 2; ++i_) o_[h_][i_] = o_[h_][i_] * (unsigned)RB + (unsigned)(gC[i_] * 2); } while (0)
#define PG8_STAGE_A(bufoff, gk, h) do { if constexpr (GATHER) { PG8_STAGE(bufoff, gk, cvo[h]); } else { PG8_STAGE(bufoff, (gk) + (h) * hstep, voffA); } } while (0)
    const unsigned ldsw = (unsigned)wid * 1024u;
    const int aoff = lds_byte(wr * 64 + fr, fq * 8), boff = lds_byte(wc * 32 + fr, fq * 8);
#define PG8_SA(b, h) (((b) * 2 + (h)) * HTB)
#define PG8_SB(b, h) ((4 + (b) * 2 + (h)) * HTB)
#define PG8_STAGE(bufoff, gbase, voff) do { _Pragma("unroll") for (int _i = 0; _i < 2; ++_i) \
        __builtin_amdgcn_global_load_lds((const unsigned*)((const char*)(gbase) + (voff)[_i]), (LAS unsigned*)(lds + (bufoff) + ldsw + _i * 8192), 16, 0, 0); } while (0)
#define PG8_LDA(dst, b, h) do { _Pragma("unroll") for (int m = 0; m < 4; ++m) _Pragma("unroll") for (int k = 0; k < 2; ++k) dst[m][k] = *(const LAS bf16x8*)(lds + PG8_SA(b, h) + aoff + m * 2048 + k * 1024); } while (0)
#define PG8_LDB(dst, b, h) do { _Pragma("unroll") for (int n = 0; n < 2; ++n) _Pragma("unroll") for (int k = 0; k < 2; ++k) dst[n][k] = *(const LAS bf16x8*)(lds + PG8_SB(b, h) + boff + n * 2048 + k * 1024); } while (0)
#define PG8_MMA(ai, bj, At, Bt) do { __builtin_amdgcn_s_setprio(1); _Pragma("unroll") for (int m = 0; m < 4; ++m) _Pragma("unroll") for (int n = 0; n < 2; ++n) { \
        if constexpr (MODE == 0) { _Pragma("unroll") for (int k = 0; k < 2; ++k) acc[ai][bj][m][n] = __builtin_amdgcn_mfma_f32_16x16x32_bf16(Bt[n][k], At[m][k], acc[ai][bj][m][n], 0, 0, 0); } \
        else if constexpr (MODE == 2) { _Pragma("unroll") for (int k = 0; k < 2; ++k) acc[ai][bj][m][n] = __builtin_bit_cast(f32x4, __builtin_amdgcn_mfma_i32_16x16x64_i8(__builtin_bit_cast(i32x4, Bt[n][k]), __builtin_bit_cast(i32x4, At[m][k]), __builtin_bit_cast(i32x4, acc[ai][bj][m][n]), 0, 0, 0)); } \
        else { const i32x8 b8_ = __builtin_shufflevector(__builtin_bit_cast(i32x4, Bt[n][0]), __builtin_bit_cast(i32x4, Bt[n][1]), 0, 1, 2, 3, 4, 5, 6, 7); \
               const i32x8 a8_ = __builtin_shufflevector(__builtin_bit_cast(i32x4, At[m][0]), __builtin_bit_cast(i32x4, At[m][1]), 0, 1, 2, 3, 4, 5, 6, 7); \
               asm volatile("v_mfma_scale_f32_16x16x128_f8f6f4 %0, %1, %2, %0, %3, %4 op_sel_hi:[0,0,0]" : "+v"(acc[ai][bj][m][n]) : "v"(b8_), "v"(a8_), "v"(wscale), "v"(ascale)); } } \
        __builtin_amdgcn_s_setprio(0); } while (0)
#define PG8_WAIT_V(n) asm volatile("s_waitcnt vmcnt(" #n ")" ::: "memory")
#define PG8_WAIT_L(n) asm volatile("s_waitcnt lgkmcnt(" #n ")" ::: "memory")
#define PG8_BAR __builtin_amdgcn_s_barrier()
#define PG8_SCHED __builtin_amdgcn_sched_barrier(0)
    Unit cur, nxt; int ui = 0;
    if (!S.next(0, cur)) return;
    f32x4 acc[2][2][4][2];
#pragma unroll
    for (int a = 0; a < 2; ++a)
#pragma unroll
        for (int b = 0; b < 2; ++b)
#pragma unroll
            for (int m = 0; m < 4; ++m)
#pragma unroll
                for (int n = 0; n < 2; ++n) acc[a][b][m][n] = (f32x4){0.f, 0.f, 0.f, 0.f};
    bf16x8 At[4][2], B0[2][2], B1[2][2];
    const char* cA = cur.A; const char* cB = cur.B;
    if constexpr (GATHER) { PG8_GTOK(cur, cvo); PG8_GOFF(cvo); }
    PG8_STAGE(PG8_SB(0, 0), cB, voffB); PG8_STAGE(PG8_SB(0, 1), cB + hstepB, voffB); PG8_STAGE_A(PG8_SA(0, 0), cA, 0); PG8_STAGE_A(PG8_SA(0, 1), cA, 1);
    if (wr == 1) PG8_BAR;
    PG8_WAIT_V(2); PG8_BAR;
    PG8_STAGE(PG8_SB(1, 0), cB + kstep, voffB); PG8_STAGE_A(PG8_SA(1, 0), cA + kstep, 0); PG8_STAGE(PG8_SB(1, 1), cB + hstepB + kstep, voffB);
    PG8_WAIT_V(6); PG8_BAR;
    for (;;) {
        const bool has_next = S.next(ui + 1, nxt);
        const char* nA = has_next ? nxt.A : cA; const char* nB = has_next ? nxt.B : cB;
        if constexpr (GATHER) { if (has_next) PG8_GTOK(nxt, nvo); }
        for (int t = 0; t < nt; t += 2) {
            const bool last = (t == nt - 2);
            const char* a1 = cA + (size_t)(t + 1) * kstep;
            const char* a2 = last ? nA : cA + (size_t)(t + 2) * kstep; const char* b2 = last ? nB : cB + (size_t)(t + 2) * kstep;
            const char* a3 = a2 + kstep; const char* b3 = b2 + kstep;
            PG8_LDB(B0, 0, 0); PG8_LDB(B1, 0, 1); PG8_SCHED; PG8_LDA(At, 0, 0); PG8_STAGE_A(PG8_SA(1, 1), a1, 1);
            if constexpr (GATHER) { if (last && has_next) {
                PG8_GOFF(nvo);
#pragma unroll
                for (int h_ = 0; h_ < 2; ++h_) { cvo[h_][0] = nvo[h_][0]; cvo[h_][1] = nvo[h_][1]; } } }
            PG8_WAIT_V(8); PG8_WAIT_L(0); PG8_BAR; PG8_MMA(0, 0, At, B0); PG8_MMA(0, 1, At, B1); PG8_BAR; PG8_SCHED;
            PG8_LDA(At, 0, 1); PG8_STAGE(PG8_SB(0, 0), b2, voffB); PG8_STAGE(PG8_SB(0, 1), b2 + hstepB, voffB); PG8_STAGE_A(PG8_SA(0, 0), a2, 0);
            PG8_WAIT_V(8); PG8_WAIT_L(0); PG8_BAR; PG8_MMA(1, 0, At, B0); PG8_MMA(1, 1, At, B1); PG8_BAR; PG8_SCHED;
            PG8_LDB(B0, 1, 0); PG8_LDB(B1, 1, 1); PG8_SCHED; PG8_LDA(At, 1, 0); PG8_STAGE_A(PG8_SA(0, 1), a2, 1);
            PG8_WAIT_V(8); PG8_WAIT_L(0); PG8_BAR; PG8_MMA(0, 0, At, B0); PG8_MMA(0, 1, At, B1); PG8_BAR; PG8_SCHED;
            PG8_LDA(At, 1, 1); PG8_STAGE(PG8_SB(1, 0), b3, voffB); PG8_STAGE(PG8_SB(1, 1), b3 + hstepB, voffB); PG8_STAGE_A(PG8_SA(1, 0), a3, 0);
            PG8_WAIT_V(8); PG8_WAIT_L(0); PG8_BAR; PG8_MMA(1, 0, At, B0); PG8_MMA(1, 1, At, B1); PG8_BAR; PG8_SCHED;
        }
        if constexpr (MODE == 1) asm volatile("s_nop 15\n\ts_nop 15" ::: "memory");
        if (wr == 0) PG8_BAR;
        E(acc, cur, wr, wc, fr, fq);
        if (!has_next) break;
#pragma unroll
        for (int a = 0; a < 2; ++a)
#pragma unroll
            for (int b = 0; b < 2; ++b)
#pragma unroll
                for (int m = 0; m < 4; ++m)
#pragma unroll
                    for (int n = 0; n < 2; ++n) acc[a][b][m][n] = (f32x4){0.f, 0.f, 0.f, 0.f};
        cur = nxt; cA = nA; cB = nB; ++ui;
        if (wr == 1) PG8_BAR;
    }
    PG8_WAIT_V(0);
    PG8_BAR;
#undef PG8_SA
#undef PG8_GOFF
#undef PG8_GTOK
#undef PG8_STAGE_A
#undef PG8_SB
#undef PG8_STAGE
#undef PG8_LDA
#undef PG8_LDB
#undef PG8_MMA
#undef PG8_WAIT_V
#undef PG8_WAIT_L
#undef PG8_BAR
#undef PG8_SCHED
}
}

namespace att {
enum { ORDER_NATURAL = 0, ORDER_REVERSED = 1, ORDER_PAIRED = 2, ORDER_XCD = 4 };
constexpr int D = 128;
constexpr int QP = NP1, KVP = NP1, OP = 16 * 256;
constexpr float THR = 8.f;
constexpr bool WSKIP = false;
constexpr float SCALE = 0.08838834764831845f;
constexpr int NW = 8, QBLK = 32, KVBLK = 64, QB = NW * QBLK;
constexpr int SHM_V = KVBLK * D * 2, SHM_K = KVBLK * D * 2;
constexpr int LDS_BYTES = 2 * SHM_V + 2 * SHM_K + NW * 64 * 4;
using bf16 = __hip_bfloat16;
template <class A, class Bt> struct same_t { static constexpr bool v = false; };
template <class A> struct same_t<A, A> { static constexpr bool v = true; };

#define KSWZ(row, colB) ((row) * 256 + ((colB) ^ (((row) & 7) << 4)))
#define SBAR() __builtin_amdgcn_sched_barrier(0)
__device__ __forceinline__ int v_st(int k, int c) { const int kk = (k & ~0xC) | ((k & 4) << 1) | ((k & 8) >> 1); return ((kk >> 3) * 4 + (c >> 5)) * 512 + ((kk & 7) * 32 + (c & 31)) * 2; }
__device__ __forceinline__ int v_rd_base(int lane) { return ((lane & 3) << 3) | (((lane >> 2) & 3) << 6) | (((lane >> 4) & 1) << 5) | (((lane >> 5) & 1) << 8); }
constexpr int v_rd_off(int d0, int ks, int half) { return d0 * 512 + ks * 4096 + half * 2048; }
__device__ __forceinline__ int crow(int r, int hi) { return (r & 3) + 8 * (r >> 2) + 4 * hi; }
__device__ __forceinline__ unsigned cvtpk(float lo, float hi) {
    unsigned r; asm volatile("v_cvt_pk_bf16_f32 %0, %1, %2" : "=v"(r) : "v"(lo), "v"(hi)); return r;
}
__device__ __forceinline__ bf16x8 pack8(f32x4 a, f32x4 b) {
    u32x4 w = {cvtpk(a[0], a[1]), cvtpk(a[2], a[3]), cvtpk(b[0], b[1]), cvtpk(b[2], b[3])};
    return *reinterpret_cast<bf16x8*>(&w);
}
template <class T> __device__ __forceinline__ bf16x8 load8(const T* p) {
    if constexpr (same_t<T, float>::v) { return pack8(*(const f32x4*)p, *(const f32x4*)(p + 4)); }
    else { return *reinterpret_cast<const bf16x8*>(p); }
}
__device__ __forceinline__ void mask_tile(f32x16& p0, f32x16& p1, int dq, unsigned W) {
    const float NEG = -__builtin_inff();
#pragma unroll
    for (int r = 0; r < 16; ++r) {
        const int c = (r & 3) + 8 * (r >> 2);
        if ((unsigned)(dq - c) >= W) p0[r] = NEG;
        if ((unsigned)(dq - c - 32) >= W) p1[r] = NEG;
    }
}
__device__ __forceinline__ void partialSM(f32x16& p0, f32x16& p1, float& m_reg, float& mn, float& alpha) {
    float pmax = p0[0]; for (int r = 1; r < 16; ++r) pmax = fmaxf(pmax, p0[r]); for (int r = 0; r < 16; ++r) pmax = fmaxf(pmax, p1[r]);
    { auto rr = __builtin_amdgcn_permlane32_swap(__float_as_uint(pmax), __float_as_uint(pmax), false, false);
      pmax = fmaxf(__uint_as_float(rr[0]), __uint_as_float(rr[1])); }
    constexpr float C2 = 1.4426950408889634f * SCALE;
    if (__builtin_expect(__all((pmax - m_reg) * SCALE <= THR), 1)) { mn = m_reg; alpha = 1.f; }
    else { mn = fmaxf(m_reg, pmax); alpha = __builtin_amdgcn_exp2f((m_reg - mn) * C2); m_reg = mn; }
    const float mnL = -mn * C2;
    for (int r = 0; r < 16; ++r) p0[r] = fmaf(p0[r], C2, mnL); for (int r = 0; r < 16; ++r) p1[r] = fmaf(p1[r], C2, mnL);
    for (int r = 0; r < 16; ++r) p0[r] = __builtin_amdgcn_exp2f(p0[r]);
}
__device__ __forceinline__ void finishSM(f32x16& p0, f32x16& p1, float alpha, float& l_reg, bf16x8& pa0, bf16x8& pa1, bf16x8& pa2, bf16x8& pa3) {
    for (int r = 0; r < 16; ++r) p1[r] = __builtin_amdgcn_exp2f(p1[r]);
    float ps = 0; for (int r = 0; r < 16; ++r) ps += p0[r]; for (int r = 0; r < 16; ++r) ps += p1[r];
    { auto rr = __builtin_amdgcn_permlane32_swap(__float_as_uint(ps), __float_as_uint(ps), false, false);
      ps = __uint_as_float(rr[0]) + __uint_as_float(rr[1]); }
    l_reg = l_reg * alpha + ps;
#define PK4(P, B_, OUT) do { unsigned a0 = cvtpk(P[B_+0], P[B_+1]), a1 = cvtpk(P[B_+2], P[B_+3]);                          \
        unsigned b0 = cvtpk(P[B_+4], P[B_+5]), b1 = cvtpk(P[B_+6], P[B_+7]);                                             \
        auto r0 = __builtin_amdgcn_permlane32_swap(a0, b0, false, false); auto r1 = __builtin_amdgcn_permlane32_swap(a1, b1, false, false); \
        u32x4 w = {r0[0], r1[0], r0[1], r1[1]}; OUT = *reinterpret_cast<bf16x8*>(&w); } while (0)
    PK4(p0, 0, pa0); PK4(p0, 8, pa1); PK4(p1, 0, pa2); PK4(p1, 8, pa3);
#undef PK4
}
template <int KB, bool SK>
__device__ __forceinline__ void qkt(f32x16& p0, f32x16& p1, const char* K_lds, int r32, int hi, const bf16x8* qr, bool act) {
    if (SK && !act) { const float NEG = -__builtin_inff();
#pragma unroll
        for (int r = 0; r < 16; ++r) { p0[r] = NEG; p1[r] = NEG; } return; }
    p0 = f32x16{}; p1 = f32x16{};
    const char* kb[4];
#pragma unroll
    for (int dd = 0; dd < 4; ++dd) kb[dd] = K_lds + KB * SHM_K + KSWZ(r32, (dd * 16 + hi * 8) * 2);
#pragma unroll
    for (int d0 = 0; d0 < 8; ++d0) { const char* a = kb[d0 & 3] + (d0 >> 2) * 128;
        bf16x8 b0 = *reinterpret_cast<const bf16x8*>(a);
        bf16x8 b1 = *reinterpret_cast<const bf16x8*>(a + 32 * 256);
        p0 = __builtin_amdgcn_mfma_f32_32x32x16_bf16(b0, qr[d0], p0, 0, 0, 0);
        p1 = __builtin_amdgcn_mfma_f32_32x32x16_bf16(b1, qr[d0], p1, 0, 0, 0); }
}
template <int VB, bool SK>
__device__ __forceinline__ void pv_tile(f32x16* o, int vb0, bf16x8 pa0, bf16x8 pa1, bf16x8 pa2, bf16x8 pa3, bool act) {
    if (SK && !act) return;
#define TRRD(dst, off) asm volatile("ds_read_b64_tr_b16 %0, %1 offset:%2" : "=&v"(dst) : "v"(vb0), "i"(off) : "memory")
#define PV_D0(d0) do { s16x4 l0, l1, l2, l3, h0, h1, h2, h3; constexpr int b_ = VB * SHM_V + v_rd_off(d0, 0, 0);     \
        TRRD(l0, b_); TRRD(h0, b_ + 2048); TRRD(l1, b_ + 4096); TRRD(h1, b_ + 6144); TRRD(l2, b_ + 8192); TRRD(h2, b_ + 10240); TRRD(l3, b_ + 12288); TRRD(h3, b_ + 14336); \
        asm volatile("s_waitcnt lgkmcnt(0)" ::: "memory"); SBAR();                 \
        o[d0] = __builtin_amdgcn_mfma_f32_32x32x16_bf16(pa0, (bf16x8){l0[0], l0[1], l0[2], l0[3], h0[0], h0[1], h0[2], h0[3]}, o[d0], 0, 0, 0);   \
        o[d0] = __builtin_amdgcn_mfma_f32_32x32x16_bf16(pa1, (bf16x8){l1[0], l1[1], l1[2], l1[3], h1[0], h1[1], h1[2], h1[3]}, o[d0], 0, 0, 0);   \
        o[d0] = __builtin_amdgcn_mfma_f32_32x32x16_bf16(pa2, (bf16x8){l2[0], l2[1], l2[2], l2[3], h2[0], h2[1], h2[2], h2[3]}, o[d0], 0, 0, 0);   \
        o[d0] = __builtin_amdgcn_mfma_f32_32x32x16_bf16(pa3, (bf16x8){l3[0], l3[1], l3[2], l3[3], h3[0], h3[1], h3[2], h3[3]}, o[d0], 0, 0, 0); } while (0)
    PV_D0(0); PV_D0(1); PV_D0(2); PV_D0(3);
#undef PV_D0
#undef TRRD
}

template <class TIn, class TOut> struct BlockRef { const TIn* Q; const TIn* K; const TIn* V; TOut* O; int P0; };
template <class TIn> struct Seam {
    bf16x8 qr[8];
    bf16x8 st_v0, st_v1, st_k0, st_k1; f32x4 sf0, sf1, sf2, sf3;
    f32x4 tq[16];
};
__device__ __forceinline__ int swa_jlo(int P0, int W) { const int lowk = P0 - W + 1; return lowk > 0 ? lowk / KVBLK : 0; }
#define ROW(p, k0, rr) ((p) + (size_t)((k0) + (rr)) * KVP + sc)
#define VMW() asm volatile("s_waitcnt vmcnt(0)" ::: "memory")
#define VMWN(n) asm volatile("s_waitcnt vmcnt(%0)" :: "i"(n) : "memory")
#define SLOAD_H(Kp, Vp, k0) do { const __amdgpu_buffer_rsrc_t rk_ = __builtin_amdgcn_make_buffer_rsrc((void*)(Kp), 0, 0x7fffffff, 0x00020000), rv_ = __builtin_amdgcn_make_buffer_rsrc((void*)(Vp), 0, 0x7fffffff, 0x00020000); const int so_ = (k0) * (KVP * 2); \
                         S.st_v0 = __builtin_bit_cast(bf16x8, __builtin_amdgcn_raw_buffer_load_b128(rv_, lo0, so_, 0)); S.st_v1 = __builtin_bit_cast(bf16x8, __builtin_amdgcn_raw_buffer_load_b128(rv_, lo1, so_, 0)); \
                         S.st_k0 = __builtin_bit_cast(bf16x8, __builtin_amdgcn_raw_buffer_load_b128(rk_, lo0, so_, 0)); S.st_k1 = __builtin_bit_cast(bf16x8, __builtin_amdgcn_raw_buffer_load_b128(rk_, lo1, so_, 0)); } while (0)
#define SWRITE_HK(bf) do { *(bf16x8*)(K_lds + (bf) * SHM_K + kws) = S.st_k0; *(bf16x8*)(K_lds + (bf) * SHM_K + kws + 32 * 256) = S.st_k1; } while (0)
#define SWRITE_HV(bf) do { *(bf16x8*)(V_lds + (bf) * SHM_V + vst0) = S.st_v0; *(bf16x8*)(V_lds + (bf) * SHM_V + vst1) = S.st_v1; } while (0)
#define SWRITE_H(bf) do { SWRITE_HV(bf); SWRITE_HK(bf); } while (0)
#define SLOAD_F(p, k0) do { S.sf0 = *(const f32x4*)ROW(p, k0, sr); S.sf1 = *(const f32x4*)(ROW(p, k0, sr) + 4);                \
                            S.sf2 = *(const f32x4*)ROW(p, k0, 32 + sr); S.sf3 = *(const f32x4*)(ROW(p, k0, 32 + sr) + 4); } while (0)
#define SWRITE_KF(bf) do { *(bf16x8*)(K_lds + (bf) * SHM_K + kws) = pack8(S.sf0, S.sf1); *(bf16x8*)(K_lds + (bf) * SHM_K + kws + 32 * 256) = pack8(S.sf2, S.sf3); } while (0)
#define SWRITE_VF(bf) do { *(bf16x8*)(V_lds + (bf) * SHM_V + vst0) = pack8(S.sf0, S.sf1); *(bf16x8*)(V_lds + (bf) * SHM_V + vst1) = pack8(S.sf2, S.sf3); } while (0)
template <class TIn, class TOut>
__device__ __forceinline__ void causal_swa_prime(const BlockRef<TIn, TOut>& cur, int W, char* lds, Seam<TIn>& S) {
    constexpr bool F32 = same_t<TIn, float>::v;
    const int tid = threadIdx.x, wid = __builtin_amdgcn_readfirstlane(tid >> 6), lane = tid & 63, r32 = lane & 31, hi = lane >> 5;
    const int sr = tid >> 4, sc = (tid & 15) * 8, kws = KSWZ(sr, sc * 2); char* K_lds = lds + 2 * SHM_V; const int lo0 = (sr * KVP + sc) * 2, lo1 = lo0 + 32 * KVP * 2;
    const int kb0 = swa_jlo(cur.P0, W) * KVBLK;
    { const __amdgpu_buffer_rsrc_t rq_ = __builtin_amdgcn_make_buffer_rsrc((void*)cur.Q, 0, 0x7fffffff, 0x00020000); const int qo_ = ((wid * QBLK + r32) * QP + hi * 8) * 2;
    _Pragma("unroll") for (int d0 = 0; d0 < 8; ++d0) S.qr[d0] = __builtin_bit_cast(bf16x8, __builtin_amdgcn_raw_buffer_load_b128(rq_, qo_ + d0 * 32, 0, 0)); }
    if constexpr (F32) { SLOAD_F((const float*)cur.K, kb0); VMW(); SWRITE_KF(0); SBAR(); SLOAD_F((const float*)cur.V, kb0); }
    else { SLOAD_H(cur.K, cur.V, kb0); VMW(); SWRITE_HK(0); }
    __syncthreads();
}
template <class TIn, class TOut>
__device__ __forceinline__ void causal_swa_block(const BlockRef<TIn, TOut>& cur, const BlockRef<TIn, TOut>& nxt, int skv, int W, char* lds, Seam<TIn>& S) {
    constexpr bool F32 = same_t<TIn, float>::v;
    const int tid = threadIdx.x, wid = __builtin_amdgcn_readfirstlane(tid >> 6), lane = tid & 63, r32 = lane & 31, hi = lane >> 5;
    const int j_lo = swa_jlo(cur.P0, W);
    int j_hi = (cur.P0 + QB - 1) / KVBLK + 1; if (j_hi > skv / KVBLK) j_hi = skv / KVBLK;
    const int NT = j_hi - j_lo;
    const int kbn = swa_jlo(nxt.P0, W) * KVBLK;
    const int qlo = cur.P0 + wid * QBLK, qm = qlo + r32 - 4 * hi;
    char* V_lds = lds; char* K_lds = lds + 2 * SHM_V;
    float* ws = (float*)(lds + 2 * SHM_V + 2 * SHM_K) + wid * 64; float* li_l = ws, * al_l = ws + 32;
    float m_reg = -1e30f, l_reg = 0; f32x16 o[4] = {};
    const int sr = tid >> 4, sc = (tid & 15) * 8, vst0 = v_st(sr, sc), vst1 = v_st(32 + sr, sc), kws = KSWZ(sr, sc * 2); const int lo0 = (sr * KVP + sc) * 2, lo1 = lo0 + 32 * KVP * 2;
    const int vb0 = (int)(uintptr_t)V_lds + v_rd_base(lane);
    const TIn* Kh = cur.K; const TIn* Vh = cur.V;
#define RESC(a) do { if (__any((a) < 1.f)) { if (hi == 0) al_l[r32] = (a); asm volatile("s_waitcnt lgkmcnt(0)" ::: "memory");              \
                     for (int d_ = 0; d_ < 4; ++d_) for (int r = 0; r < 16; ++r) o[d_][r] *= al_l[crow(r, hi)]; } } while (0)
#define KBASE(t) ((j_lo + (t)) * KVBLK)
#define ACT(t) (KBASE(t) <= qlo + QBLK - 1 && KBASE(t) + KVBLK - 1 >= qlo - W + 1)
#define MASKT(P0_, P1_, t) do { const int kb_ = KBASE(t); if ((!SK || ACT(t)) && (kb_ + KVBLK - 1 > qlo || kb_ <= qlo + QBLK - 1 - W)) mask_tile(P0_, P1_, qm - kb_, (unsigned)W); } while (0)
    constexpr int NQL = F32 ? 16 : 8;
    constexpr bool SK = WSKIP && !F32;
#define SEAM_K0() do { VMWN(NQL); if constexpr (F32) { SWRITE_KF(0); SBAR(); SLOAD_F((const float*)nxt.V, kbn); } else { SWRITE_HK(0); } SBAR(); } while (0)
    f32x16 pA0, pA1, pB0, pB1; float mnA, mnB, alA, alB; bf16x8 pa0, pa1, pa2, pa3;
    if constexpr (F32) { VMW(); SWRITE_VF(0); SBAR(); } else { SWRITE_HV(0); SBAR(); }
    if (NT > 1) { if constexpr (F32) SLOAD_F((const float*)Kh, KBASE(1)); else SLOAD_H(Kh, Vh, KBASE(1)); }
    SBAR(); qkt<0, SK>(pA0, pA1, K_lds, r32, hi, S.qr, ACT(0));
    if constexpr (F32) { if (NT > 1) { VMW(); SWRITE_KF(1); SBAR(); SLOAD_F((const float*)Vh, KBASE(1)); } }
    MASKT(pA0, pA1, 0); partialSM(pA0, pA1, m_reg, mnA, alA);
    if (NT > 1) { VMW(); if constexpr (F32) { SWRITE_VF(1); SBAR(); if (NT > 2) SLOAD_F((const float*)Kh, KBASE(2)); } else SWRITE_H(1); }
    __syncthreads();
#define HALF_STEP(PX0, PX1, mnX, alX, PY0, PY1, alY, t, KB, VB, SB) do {                                                      \
        SBAR(); qkt<KB, SK>(PX0, PX1, K_lds, r32, hi, S.qr, ACT(t));                                             \
        finishSM(PY0, PY1, alY, l_reg, pa0, pa1, pa2, pa3); SBAR();                                                           \
        if ((t) + 1 < NT) { if constexpr (F32) { VMW(); SWRITE_KF(SB); SBAR(); SLOAD_F((const float*)Vh, KBASE((t) + 1)); }  \
                            else { SLOAD_H(Kh, Vh, KBASE((t) + 1)); } SBAR(); }                                               \
        pv_tile<VB, SK>(o, vb0, pa0, pa1, pa2, pa3, ACT((t) - 1)); MASKT(PX0, PX1, (t)); partialSM(PX0, PX1, m_reg, mnX, alX);                                        \
        __syncthreads();                                                                                                      \
        if ((t) + 1 < NT) { VMW(); if constexpr (F32) { SWRITE_VF(SB); SBAR(); if ((t) + 2 < NT) SLOAD_F((const float*)Kh, KBASE((t) + 2)); } \
                            else { SWRITE_H(SB); } }                                                                          \
        RESC(alX); __syncthreads(); } while (0)
    for (int t = 1; t + 1 < NT; t += 2) {
        HALF_STEP(pB0, pB1, mnB, alB, pA0, pA1, alA, t, 1, 0, 0);
        HALF_STEP(pA0, pA1, mnA, alA, pB0, pB1, alB, t + 1, 0, 1, 1);
    }
    const bool even = (NT & 1) == 0;
    if (even) { SBAR(); qkt<1, SK>(pB0, pB1, K_lds, r32, hi, S.qr, ACT(NT - 1)); SBAR(); }
#define QROW(e) (nxt.Q + (size_t)(wid * QBLK + r32) * QP + ((e) >> 1) * 16 + hi * 8 + ((e) & 1) * 4)
    if constexpr (F32) { SLOAD_F((const float*)nxt.K, kbn); SBAR();
#pragma unroll
        for (int e = 0; e < 8; ++e) S.tq[e] = *(const f32x4*)QROW(e); }
    else { SLOAD_H(nxt.K, nxt.V, kbn); SBAR();
        { const __amdgpu_buffer_rsrc_t rq_ = __builtin_amdgcn_make_buffer_rsrc((void*)nxt.Q, 0, 0x7fffffff, 0x00020000); const int qo_ = ((wid * QBLK + r32) * QP + hi * 8) * 2;
        _Pragma("unroll") for (int d0 = 0; d0 < 8; ++d0) S.qr[d0] = __builtin_bit_cast(bf16x8, __builtin_amdgcn_raw_buffer_load_b128(rq_, qo_ + d0 * 32, 0, 0)); } }
    SBAR();
    finishSM(pA0, pA1, alA, l_reg, pa0, pa1, pa2, pa3); SBAR();
    if constexpr (F32) {
#pragma unroll
        for (int e = 8; e < 16; ++e) S.tq[e] = *(const f32x4*)QROW(e); SBAR(); }
#undef QROW
    pv_tile<0, SK>(o, vb0, pa0, pa1, pa2, pa3, ACT(even ? NT - 2 : NT - 1));
    if (even) { MASKT(pB0, pB1, NT - 1); partialSM(pB0, pB1, m_reg, mnB, alB); __syncthreads(); RESC(alB);
        finishSM(pB0, pB1, alB, l_reg, pa0, pa1, pa2, pa3); SBAR(); pv_tile<1, SK>(o, vb0, pa0, pa1, pa2, pa3, ACT(NT - 1)); }
    SBAR(); SEAM_K0();
    if (hi == 0) li_l[r32] = l_reg; asm volatile("s_waitcnt lgkmcnt(0)" ::: "memory");
    float rli[16];
#pragma unroll
    for (int r = 0; r < 16; ++r) rli[r] = __builtin_amdgcn_rcpf(li_l[crow(r, hi)]);
    TOut* Ow = cur.O + (size_t)(wid * QBLK) * OP;
#pragma unroll
    for (int r = 0; r < 16; ++r) { const int orow = crow(r, hi);
#pragma unroll
        for (int d0 = 0; d0 < 4; ++d0) { const float v = o[d0][r] * rli[r];
            if constexpr (same_t<TOut, float>::v) { Ow[(size_t)orow * OP + d0 * 32 + r32] = v; }
            else { const float vn = __shfl_xor(v, 1);
                   if ((r32 & 1) == 0) *(unsigned*)(Ow + (size_t)orow * OP + d0 * 32 + r32) = cvtpk(v, vn); } } }
    if constexpr (F32) {
#pragma unroll
        for (int d0 = 0; d0 < 8; ++d0) S.qr[d0] = pack8(S.tq[2 * d0], S.tq[2 * d0 + 1]); }
    __syncthreads();
#undef RESC
#undef KBASE
#undef ACT
#undef MASKT
#undef SEAM_K0
#undef HALF_STEP
}
#undef ROW
#undef VMW
#undef VMWN
#undef SLOAD_H
#undef SWRITE_HK
#undef SWRITE_HV
#undef SWRITE_H
#undef SLOAD_F
#undef SWRITE_KF
#undef SWRITE_VF

}

namespace att2 {
using att::bf16;
constexpr int D = 128, KVP = NP1, QP = NP1, OP = 16 * 256, KVBLK = 64, QB = 128;
constexpr int SHM = KVBLK * D * 2;
constexpr int L_K = 0, L_V = 2 * SHM, L_P = L_V + 4 * SHM, L_LI = L_P + 2 * 4 * 4096, L_END = L_LI + 1024;
static_assert(L_END <= RING_BYTES, "attention LDS");
constexpr float SCALE = 0.08838834764831845f, C2 = 1.4426950408889634f * SCALE;
struct Block { const bf16* Q; const bf16* K; const bf16* V; bf16* O; int P0; };
__device__ __forceinline__ u32x4 bload(__amdgpu_buffer_rsrc_t r, int voff, int soff) { return __builtin_bit_cast(u32x4, __builtin_amdgcn_raw_buffer_load_b128(r, voff, soff, 0)); }
#define A2_TRRD(dst, base, off) asm volatile("ds_read_b64_tr_b16 %0, %1 offset:%2" : "=&v"(dst) : "v"(base), "i"(off) : "memory")
#define A2_PV(o_, vbase, IMG, d0) do { s16x4 l0, l1, l2, l3, h0, h1, h2, h3; constexpr int b_ = (IMG) + att::v_rd_off(d0, 0, 0); \
        A2_TRRD(l0, vbase, b_); A2_TRRD(h0, vbase, b_ + 2048); A2_TRRD(l1, vbase, b_ + 4096); A2_TRRD(h1, vbase, b_ + 6144); A2_TRRD(l2, vbase, b_ + 8192); A2_TRRD(h2, vbase, b_ + 10240); A2_TRRD(l3, vbase, b_ + 12288); A2_TRRD(h3, vbase, b_ + 14336); \
        asm volatile("s_waitcnt lgkmcnt(0)" ::: "memory"); __builtin_amdgcn_sched_barrier(0); \
        o_ = __builtin_amdgcn_mfma_f32_32x32x16_bf16(pa0, (bf16x8){l0[0], l0[1], l0[2], l0[3], h0[0], h0[1], h0[2], h0[3]}, o_, 0, 0, 0); \
        o_ = __builtin_amdgcn_mfma_f32_32x32x16_bf16(pa1, (bf16x8){l1[0], l1[1], l1[2], l1[3], h1[0], h1[1], h1[2], h1[3]}, o_, 0, 0, 0); \
        o_ = __builtin_amdgcn_mfma_f32_32x32x16_bf16(pa2, (bf16x8){l2[0], l2[1], l2[2], l2[3], h2[0], h2[1], h2[2], h2[3]}, o_, 0, 0, 0); \
        o_ = __builtin_amdgcn_mfma_f32_32x32x16_bf16(pa3, (bf16x8){l3[0], l3[1], l3[2], l3[3], h3[0], h3[1], h3[2], h3[3]}, o_, 0, 0, 0); } while (0)
#define A2_PK4(P, B_, OUT) do { unsigned a0_ = att::cvtpk(P[B_+0], P[B_+1]), a1_ = att::cvtpk(P[B_+2], P[B_+3]), b0_ = att::cvtpk(P[B_+4], P[B_+5]), b1_ = att::cvtpk(P[B_+6], P[B_+7]); \
        auto r0_ = __builtin_amdgcn_permlane32_swap(a0_, b0_, false, false); auto r1_ = __builtin_amdgcn_permlane32_swap(a1_, b1_, false, false); \
        u32x4 w_ = {r0_[0], r1_[0], r0_[1], r1_[1]}; OUT = __builtin_bit_cast(bf16x8, w_); } while (0)
__device__ __forceinline__ void block(const Block& B, char* lds, const float mref) {
    const int tid = threadIdx.x, wid = __builtin_amdgcn_readfirstlane(tid >> 6), lane = tid & 63, r32 = lane & 31, hi = lane >> 5; const int rg = wid & 3, kh = wid >> 2;
    const int NT = B.P0 / KVBLK + 2;
    const int qlo = B.P0 + rg * 32, qm = qlo + r32 - 4 * hi;
    const int sr = tid >> 4, sc = (tid & 15) * 8, kws = KSWZ(sr, sc * 2), vst0 = att::v_st(sr, sc), vst1 = att::v_st(32 + sr, sc);
    const int lo0 = (sr * KVP + sc) * 2, lo1 = lo0 + 32 * KVP * 2;
    const __amdgpu_buffer_rsrc_t rk = __builtin_amdgcn_make_buffer_rsrc((void*)B.K, 0, 0x7fffffff, 0x00020000), rv = __builtin_amdgcn_make_buffer_rsrc((void*)B.V, 0, 0x7fffffff, 0x00020000);
    const int vb0 = (int)(uintptr_t)(lds + L_V + kh * SHM) + att::v_rd_base(lane);
    char* Pmine = lds + L_P + rg * 4096 + (2 * kh) * 1024 + lane * 16;
    const char* Ppart = lds + L_P + rg * 4096 + (2 * (kh ^ 1)) * 1024 + lane * 16;
    u32x4 sk0, sk1, sa0, sa1, sb0, sb1;
#define A2_LOADK(t_) do { const int so_ = (t_) * KVBLK * KVP * 2; sk0 = bload(rk, lo0, so_); sk1 = bload(rk, lo1, so_); } while (0)
#define A2_LOADV(t_) do { const int so_ = (t_) * KVBLK * KVP * 2; sa0 = bload(rv, lo0, so_); sa1 = bload(rv, lo1, so_); sb0 = bload(rv, lo0 + 256, so_); sb1 = bload(rv, lo1 + 256, so_); } while (0)
#define A2_WRITEK(par) do { *(u32x4*)(lds + L_K + (par) * SHM + kws) = sk0; *(u32x4*)(lds + L_K + (par) * SHM + kws + 32 * 256) = sk1; } while (0)
#define A2_WRITEV(par) do { char* v_ = lds + L_V + (par) * 2 * SHM; *(u32x4*)(v_ + vst0) = sa0; *(u32x4*)(v_ + vst1) = sa1; *(u32x4*)(v_ + SHM + vst0) = sb0; *(u32x4*)(v_ + SHM + vst1) = sb1; } while (0)
    bf16x8 qr[8]; f32x16 o[4] = {}; float l_reg = 0.f; bf16x8 my0, my1;
    A2_LOADK(0);
    { const __amdgpu_buffer_rsrc_t rq = __builtin_amdgcn_make_buffer_rsrc((void*)B.Q, 0, 0x7fffffff, 0x00020000); const int qo = ((rg * 32 + r32) * QP + hi * 8) * 2;
#pragma unroll
      for (int d0 = 0; d0 < 8; ++d0) qr[d0] = __builtin_bit_cast(bf16x8, bload(rq, qo + d0 * 32, 0)); }
    asm volatile("s_waitcnt vmcnt(0)" ::: "memory");
    A2_WRITEK(0);
    A2_LOADK(1); A2_LOADV(0);
    __syncthreads();
    for (int t = 0; t <= NT; ++t) {
        const bool sc_ = t < NT, k1 = t + 1 < NT;
        asm volatile("s_waitcnt vmcnt(0)" ::: "memory");
        if (k1) A2_WRITEK((t + 1) & 1);
        if (sc_) A2_WRITEV(t & 1);
        if (t + 2 < NT) A2_LOADK(t + 2);
        if (k1) A2_LOADV(t + 1);
        bf16x8 pv0 = my0, pv1 = my1;
        if (sc_) {
            const int kb0 = t * KVBLK + 32 * kh;
            if (kb0 > qlo + 31) { my0 = bf16x8{}; my1 = bf16x8{}; }
            else {
                f32x16 p = {}; const char* kb_[4];
#pragma unroll
                for (int dd = 0; dd < 4; ++dd) kb_[dd] = lds + L_K + (t & 1) * SHM + kh * 32 * 256 + KSWZ(r32, (dd * 16 + hi * 8) * 2);
#pragma unroll
                for (int d0 = 0; d0 < 8; ++d0) p = __builtin_amdgcn_mfma_f32_32x32x16_bf16(*reinterpret_cast<const bf16x8*>(kb_[d0 & 3] + (d0 >> 2) * 128), qr[d0], p, 0, 0, 0);
                if (kb0 + 31 > qlo) { const int dq = qm - kb0; const float NEG = -__builtin_inff();
#pragma unroll
                    for (int r = 0; r < 16; ++r) { const int c = (r & 3) + 8 * (r >> 2); if ((unsigned)(dq - c) >= (unsigned)SEQ) p[r] = NEG; } }
                const float mnl = -mref * C2; float ps = 0.f;
#pragma unroll
                for (int r = 0; r < 16; ++r) { p[r] = __builtin_amdgcn_exp2f(fmaf(p[r], C2, mnl)); ps += p[r]; }
                { auto rr = __builtin_amdgcn_permlane32_swap(__float_as_uint(ps), __float_as_uint(ps), false, false); l_reg += __uint_as_float(rr[0]) + __uint_as_float(rr[1]); }
                A2_PK4(p, 0, my0); A2_PK4(p, 8, my1);
            }
            char* pw = Pmine + (t & 1) * 4 * 4096; *(bf16x8*)pw = my0; *(bf16x8*)(pw + 1024) = my1;
        }
        if (t >= 1 && (t - 1) * KVBLK <= qlo + 31) {
            const char* pr = Ppart + ((t - 1) & 1) * 4 * 4096; const bf16x8 ot0 = *(const bf16x8*)pr, ot1 = *(const bf16x8*)(pr + 1024);
            const bf16x8 pa0 = kh ? ot0 : pv0, pa1 = kh ? ot1 : pv1, pa2 = kh ? pv0 : ot0, pa3 = kh ? pv1 : ot1;
            const int vb = vb0 + ((t - 1) & 1) * 2 * SHM;
            A2_PV(o[0], vb, 0, 0); A2_PV(o[1], vb, 0, 1); A2_PV(o[2], vb, 0, 2); A2_PV(o[3], vb, 0, 3);
        }
        __syncthreads();
    }
    float* li = (float*)(lds + L_LI);
    if (hi == 0) li[(kh * 4 + rg) * 32 + r32] = l_reg;
    __syncthreads();
    float rli[16];
#pragma unroll
    for (int r = 0; r < 16; ++r) rli[r] = __builtin_amdgcn_rcpf(li[rg * 32 + att::crow(r, hi)] + li[(4 + rg) * 32 + att::crow(r, hi)]);
    bf16* Ow = B.O + (size_t)(rg * 32) * OP + kh * 128;
#pragma unroll
    for (int d0 = 0; d0 < 4; ++d0)
#pragma unroll
        for (int r = 0; r < 16; ++r) { const float v = o[d0][r] * rli[r]; const float vn = __shfl_xor(v, 1);
            if ((r32 & 1) == 0) *(unsigned*)(Ow + (size_t)att::crow(r, hi) * OP + d0 * 32 + r32) = att::cvtpk(v, vn); }
    __syncthreads();
#undef A2_LOADK
#undef A2_LOADV
#undef A2_WRITEK
#undef A2_WRITEV
}
#undef A2_PK4
#undef A2_TRRD
#undef A2_PV
}

#define XB_TMO      128
#define XB_XCNT(j)  (256  + 64 * (j))
#define XB_XSUB(j)  (1280 + 64 * (j))
#define XB_XGEN(j)  (2304 + 64 * (j))
#define XB_TOP      3328
#define XB_TOPGEN   3392
#define XCD_BAR_WORDS 3456
#define XB_SPIN_CAP (1u << 18)
__device__ __forceinline__ unsigned xb_ld(unsigned* p)              { return __hip_atomic_load(p, __ATOMIC_RELAXED, __HIP_MEMORY_SCOPE_AGENT); }
__device__ __forceinline__ unsigned xb_add(unsigned* p, unsigned v) { return __hip_atomic_fetch_add(p, v, __ATOMIC_RELAXED, __HIP_MEMORY_SCOPE_AGENT); }
__device__ __forceinline__ unsigned xb_xcc_id() { return (unsigned)__builtin_amdgcn_s_getreg((3 << 11) | 20) & 0xFu; }
#define XB_SPIN(cond, bar) do { unsigned _sp = 0; while (cond) { __builtin_amdgcn_s_sleep(1); \
    if ((++_sp & 255u) == 0u) { if (xb_ld(&(bar)[XB_TMO])) break; if (_sp > XB_SPIN_CAP) { atomicAdd(&(bar)[XB_TMO], 1u); break; } } } } while (0)
struct XcdBarrier { unsigned* bar; unsigned x; volatile LAS unsigned* st; };
__device__ __forceinline__ XcdBarrier xcd_barrier_post(unsigned* bar, volatile LAS unsigned* st) {
    XcdBarrier b; b.bar = bar; b.x = xb_xcc_id(); b.st = st;
    if (threadIdx.x == 0) (void)xb_add(&bar[XB_XCNT(b.x)], 1u);
    return b;
}
__device__ __forceinline__ void xcd_barrier_complete(unsigned* bar, unsigned x, unsigned& nloc, unsigned& nx) {
    const unsigned G = gridDim.x * gridDim.y * gridDim.z;
    unsigned sum, cnt, mine, sp = 0u;
    for (;;) {
        sum = 0u; cnt = 0u; mine = 0u;
#pragma unroll
        for (unsigned j = 0; j < 16; ++j) { const unsigned c = xb_ld(&bar[XB_XCNT(j)]); sum += c; cnt += (c > 0u) ? 1u : 0u; mine = (j == x) ? c : mine; }
        if (sum == G) break;
        __builtin_amdgcn_s_sleep(1);
        if ((++sp & 255u) == 0u) { if (xb_ld(&bar[XB_TMO])) break; if (sp > XB_SPIN_CAP) { atomicAdd(&bar[XB_TMO], 1u); break; } }
    }
    nloc = mine > 0u ? mine : 1u; nx = cnt > 0u ? cnt : 1u;
}
__device__ __forceinline__ void xcd_barrier(const XcdBarrier& b) {
    asm volatile("s_waitcnt vmcnt(0)" ::: "memory");
    __syncthreads();
    if (threadIdx.x == 0) {
        unsigned* bar = b.bar;
        __builtin_amdgcn_s_waitcnt(0);
        unsigned nloc = b.st[0], nx = b.st[1];
        if (nloc == 0u) { xcd_barrier_complete(bar, b.x, nloc, nx); b.st[0] = nloc; b.st[1] = nx; }
        const unsigned old = xb_add(&bar[XB_XSUB(b.x)], 1u);
        const unsigned gen = old / nloc;
        if (old + 1u == (gen + 1u) * nloc) {
            __builtin_amdgcn_fence(__ATOMIC_RELEASE, "agent");
            asm volatile("s_waitcnt vmcnt(0)" ::: "memory");
            const unsigned og = xb_add(&bar[XB_TOP], 1u);
            const unsigned tg = og / nx;
            if (og + 1u == (tg + 1u) * nx) xb_add(&bar[XB_TOPGEN], 1u);
            else XB_SPIN(xb_ld(&bar[XB_TOPGEN]) == tg, bar);
            __builtin_amdgcn_fence(__ATOMIC_ACQUIRE, "agent");
            xb_add(&bar[XB_XGEN(b.x)], 1u);
            asm volatile("s_waitcnt vmcnt(0)" ::: "memory");
        } else {
            XB_SPIN(xb_ld(&bar[XB_XGEN(b.x)]) == gen, bar);
            __builtin_amdgcn_fence(__ATOMIC_ACQUIRE, "agent");
            asm volatile("s_waitcnt vmcnt(0)" ::: "memory");
        }
    }
    __syncthreads();
}

#define LDS_WAIT() asm volatile("s_waitcnt lgkmcnt(0)" ::: "memory")
#define VM_WAIT() asm volatile("s_waitcnt vmcnt(0)" ::: "memory")
struct Inputs {
    const float* x; const int* positions; const float* mix_norm; const float* ffn_norm; const float* hgrn_w_in; const float* hgrn_out_gain; const float* hgrn_w_out; const float* hgrn_lb;
    const float* diff_w_in; const float* diff_q_gain; const float* diff_k_gain; const float* diff_lambda; const float* diff_sub_gain; const float* diff_w_out;
    const float* moe_w_group; const float* moe_w_expert; const float* moe_w_gate; const float* moe_w_up; const float* moe_w_down;
};
struct Args { Inputs in; float* out; unsigned char* ws; int ph_lo, ph_hi; };
typedef const CAS Args* KArgs;
__device__ __forceinline__ KArgs kargs() { KArgs p = (KArgs)__builtin_amdgcn_kernarg_segment_ptr(); asm volatile("" : "+s"(p)); return p; }
struct Frame {
    LAS unsigned char* lds;
    int wave, vcu, G;
    __device__ __forceinline__ int tid() const { return (int)threadIdx.x; }
    __device__ __forceinline__ int lane() const { return (int)threadIdx.x & 63; }
    __device__ __forceinline__ unsigned char* ws() const { return kargs()->ws; }
    __device__ __forceinline__ unsigned* ctl() const { return (unsigned*)(kargs()->ws + WS_CTL); }
};
__device__ __forceinline__ float wave_sum(float v) {
#pragma unroll
    for (int o = 1; o < 64; o <<= 1) v += __shfl_xor(v, o);
    return v;
}
struct TileDesc { const float* W; unsigned char* WT; const unsigned* colmax; int ldw, ldt, k0, n0; float wmul; };
struct TileRegs { f32x4 a[16]; };
template <int MODE> __device__ __forceinline__ void tile_load(const TileDesc& t, TileRegs& R, int lane) {
    if constexpr (MODE == 0) { const int l16 = lane & 15, g = lane >> 4;
#pragma unroll
        for (int it = 0; it < 8; ++it) { const int kp = it * 4 + g; const float* p = t.W + (size_t)(t.k0 + 2 * kp) * t.ldw + t.n0 + 4 * l16; R.a[2 * it] = __builtin_nontemporal_load((const f32x4*)p); R.a[2 * it + 1] = __builtin_nontemporal_load((const f32x4*)(p + t.ldw)); }
    } else { const int l8 = lane & 7, g = lane >> 3;
#pragma unroll
        for (int it = 0; it < 4; ++it) { const int kp = it * 8 + g; const float* p = t.W + (size_t)(t.k0 + 4 * kp) * t.ldw + t.n0 + 4 * l8;
#pragma unroll
            for (int q = 0; q < 4; ++q) R.a[4 * it + q] = __builtin_nontemporal_load((const f32x4*)(p + (size_t)q * t.ldw)); } }
}
template <int MODE> __device__ __forceinline__ void tile_finish(const TileDesc& t, const TileRegs& R, LAS unsigned* scr, int lane) {
    if constexpr (MODE == 0) { const int l16 = lane & 15, g = lane >> 4;
#pragma unroll
        for (int it = 0; it < 8; ++it) { const int kp = it * 4 + g;
#pragma unroll
            for (int j = 0; j < 4; ++j) scr[(4 * l16 + j) * 33 + kp] = cvt_pk_bf16(R.a[2 * it][j], R.a[2 * it + 1][j]); }
        LDS_WAIT(); asm volatile("" ::: "memory");
        const int ch = lane & 7;
#pragma unroll
        for (int jj = 0; jj < 8; ++jj) { const int n = (lane >> 3) + 8 * jj; const LAS unsigned* sp = scr + n * 33 + 4 * ch;
            u32x4 o; o.x = sp[0]; o.y = sp[1]; o.z = sp[2]; o.w = sp[3];
            __builtin_nontemporal_store(o, (u32x4*)(t.WT + ((size_t)n * t.ldt + t.k0 + 8 * ch) * 2)); }
    } else { const int l8 = lane & 7, g = lane >> 3;
        float inv[4];
        if constexpr (MODE == 2) {
#pragma unroll
            for (int j = 0; j < 4; ++j) { const float cm = __uint_as_float(t.colmax[t.n0 + 4 * l8 + j]); inv[j] = cm > 0.f ? 127.0f / cm : 0.f; } }
#pragma unroll
        for (int it = 0; it < 4; ++it) { const int kp = it * 8 + g;
#pragma unroll
            for (int j = 0; j < 4; ++j) {
                if constexpr (MODE == 1) scr[(4 * l8 + j) * 33 + kp] = pk4_fp8(R.a[4 * it][j] * t.wmul, R.a[4 * it + 1][j] * t.wmul, R.a[4 * it + 2][j] * t.wmul, R.a[4 * it + 3][j] * t.wmul);
                else { const int q0 = (int)rintf(R.a[4 * it][j] * inv[j]), q1 = (int)rintf(R.a[4 * it + 1][j] * inv[j]), q2 = (int)rintf(R.a[4 * it + 2][j] * inv[j]), q3 = (int)rintf(R.a[4 * it + 3][j] * inv[j]);
                       scr[(4 * l8 + j) * 33 + kp] = (unsigned)(q0 & 0xff) | ((unsigned)(q1 & 0xff) << 8) | ((unsigned)(q2 & 0xff) << 16) | ((unsigned)q3 << 24); } } }
        LDS_WAIT(); asm volatile("" ::: "memory");
        const int ch = lane & 7;
#pragma unroll
        for (int jj = 0; jj < 4; ++jj) { const int n = (lane >> 3) + 8 * jj; const LAS unsigned* sp = scr + n * 33 + 4 * ch;
            u32x4 o; o.x = sp[0]; o.y = sp[1]; o.z = sp[2]; o.w = sp[3];
            __builtin_nontemporal_store(o, (u32x4*)(t.WT + (size_t)n * t.ldt + t.k0 + 16 * ch)); } }
    LDS_WAIT(); asm volatile("" ::: "memory");
}
template <int MODE> __device__ __forceinline__ TileDesc tile_desc(const float* W, int ldw, int N, void* WT, int ldt, int t, int rowadd, float wmul, const unsigned* colmax) {
    constexpr int NT = MODE ? 32 : 64, KT = MODE ? 128 : 64, ES = MODE ? 1 : 2;
    const int ntn = N / NT, kt = t / ntn, n0 = (t % ntn) * NT;
    TileDesc d; d.W = W; d.WT = (unsigned char*)WT + (size_t)(n0 + rowadd) * ldt * ES; d.colmax = colmax; d.ldw = ldw; d.ldt = ldt; d.k0 = kt * KT; d.n0 = n0; d.wmul = wmul; return d;
}
template <int MODE, class Fn> __device__ __forceinline__ void conv_loop(const int n_items, const int worker, const int nworkers, const Fn& desc, LAS unsigned* scr, const int lane) {
    int it = worker; if (it >= n_items) return;
    TileRegs R0, R1; TileDesc d0 = desc(it), d1 = d0; tile_load<MODE>(d0, R0, lane);
    for (;;) {
        const int it1 = it + nworkers; const bool h1 = it1 < n_items; if (h1) { d1 = desc(it1); tile_load<MODE>(d1, R1, lane); }
        tile_finish<MODE>(d0, R0, scr, lane);
        if (!h1) break;
        const int it2 = it1 + nworkers; const bool h2 = it2 < n_items; if (h2) { d0 = desc(it2); tile_load<MODE>(d0, R0, lane); }
        tile_finish<MODE>(d1, R1, scr, lane);
        if (!h2) break;
        it = it2;
    }
}
template <int MODE, class Fn> __device__ __forceinline__ void conv_loop_dyn(const int n_items, unsigned* ctr, const Fn& desc, LAS unsigned* scr, const int lane) {
#define CQ_PULL() ({ int v_ = 0; if (lane == 0) v_ = (int)__hip_atomic_fetch_add(ctr, 1u, __ATOMIC_RELAXED, __HIP_MEMORY_SCOPE_AGENT); __builtin_amdgcn_readfirstlane(v_); })
    int it = CQ_PULL(); if (it >= n_items) return;
    TileRegs R0, R1; TileDesc d0 = desc(it), d1 = d0; tile_load<MODE>(d0, R0, lane);
    int it1 = CQ_PULL();
    for (;;) {
        const bool h1 = it1 < n_items; int it2 = n_items; if (h1) { d1 = desc(it1); tile_load<MODE>(d1, R1, lane); it2 = CQ_PULL(); }
        tile_finish<MODE>(d0, R0, scr, lane);
        if (!h1) break;
        const bool h2 = it2 < n_items; int it3 = n_items; if (h2) { d0 = desc(it2); tile_load<MODE>(d0, R0, lane); it3 = CQ_PULL(); }
        tile_finish<MODE>(d1, R1, scr, lane);
        if (!h2) break;
        it1 = it3;
    }
#undef CQ_PULL
}
struct DescIn { int set; KArgs ka; unsigned* ctl;
    __device__ __forceinline__ TileDesc operator()(int t) const { unsigned char* ws = ka->ws;
        return set == 0 ? tile_desc<INPROJ_MODE>(ka->in.hgrn_w_in, NP0, NP0, ws + WS_WHIN, D, t, 0, (float)(1 << WSH_IN), ctl + CW_CMAX + CSC_HIN)
                        : tile_desc<INPROJ_MODE>(ka->in.diff_w_in, NP1, NP1, ws + WS_WDIN, D, t, 0, (float)(1 << WSH_IN), ctl + CW_CMAX + CSC_DIN); } };
struct DescOutI8 { int set; KArgs ka; unsigned* ctl;
    __device__ __forceinline__ TileDesc operator()(int t) const { return tile_desc<2>(set == 0 ? ka->in.hgrn_w_out : ka->in.diff_w_out, D, D, ka->ws + (set == 0 ? WS_WHOUT : WS_WDOUT), D, t, 0, 1.f, ctl + CW_CMAX + (set == 0 ? CSC_HOUT : CSC_DOUT)); } };
struct DescOut { int set; KArgs ka;
    __device__ __forceinline__ TileDesc operator()(int t) const { unsigned char* ws = ka->ws;
        return tile_desc<(FP8_OUTPROJ ? 1 : 0)>(set == 0 ? ka->in.hgrn_w_out : ka->in.diff_w_out, D, D, ws + (set == 0 ? WS_WHOUT : WS_WDOUT), D, t, 0, (float)(1 << WSH_OUT), nullptr); } };
struct DescMoe { int set; KArgs ka;
    __device__ __forceinline__ TileDesc operator()(int r) const { unsigned char* ws = ka->ws;
        constexpr int T_MOE1 = NE * 256, MM = FP8_MOE ? 1 : 0, MESZ = FP8_MOE ? 1 : 2;
        const int which = r / T_MOE1; r -= which * T_MOE1; const int le = set * NE + r / 256, t = r % 256;
        if (which < 2) {
            constexpr int NT = FP8_MOE ? 32 : 64; const int n0 = (t % (FF / NT)) * NT; const int rowadd = (n0 / 128) * 256 + (n0 % 128) + which * 128 - n0;
            return tile_desc<MM>((which == 0 ? ka->in.moe_w_gate : ka->in.moe_w_up) + (size_t)le * D * FF, FF, FF, ws + WS_WGU + (size_t)le * 1024 * D * MESZ, D, t, rowadd, (float)(1 << WSH_GU), nullptr); }
        return tile_desc<MM>(ka->in.moe_w_down + (size_t)le * FF * D, D, D, ws + WS_WDN + (size_t)le * D * FF * MESZ, FF, t, 0, (float)(1 << WSH_DN), nullptr); } };
__device__ __forceinline__ void convert_weights(Frame& F, const int set, const int worker, const int nworkers, LAS unsigned* scr, const int pct_lo = 0, const int pct_hi = 100) {
    const KArgs ka = kargs(); const int lane = F.lane();
    if (pct_lo == 0 || pct_lo == -1) {
        conv_loop<INPROJ_MODE>(set == 0 ? 32 * 128 : 32 * 96, worker, nworkers, DescIn{set, ka, F.ctl()}, scr, lane);
        if ((OUT1_I8 && set == 1) || (OUT0_I8 && set == 0)) conv_loop<2>(16 * 64, worker, nworkers, DescOutI8{set, ka, F.ctl()}, scr, lane);
        else conv_loop<(FP8_OUTPROJ ? 1 : 0)>(32 * 32, worker, nworkers, DescOut{set, ka}, scr, lane); }
    constexpr int NM = 3 * NE * 256;
    if (pct_lo < 0) { conv_loop_dyn<(FP8_MOE ? 1 : 0)>(NM, F.ctl() + CW_QUEUE, DescMoe{set, ka}, scr, lane); return; }
    const int i0 = (int)((long)NM * pct_lo / 100), i1 = (int)((long)NM * pct_hi / 100);
    conv_loop<(FP8_MOE ? 1 : 0)>(i1, i0 + worker, nworkers, DescMoe{set, ka}, scr, lane);
}
__device__ __forceinline__ void colmax_phase(Frame& F) {
    const CAS Inputs& I = kargs()->in;
    unsigned* cm = F.ctl() + CW_CMAX;
    const int gw = F.vcu * NWAVES + F.wave, NGW = F.G * NWAVES, lane = F.lane();
    constexpr int KS = 64, KR = D / KS;
    constexpr int B_HIN = NP0 / 256, B_HOUT = D / 256, B_DIN = NP1 / 256, B_DOUT = D / 256, NTASK = (B_HIN + B_HOUT + B_DIN + B_DOUT) * KS;
    for (int task = gw; task < NTASK; task += NGW) {
        int cb = task / KS; const int ks = task % KS; const float* W; int N, off;
        if (cb < B_HIN) { W = I.hgrn_w_in; N = NP0; off = CSC_HIN; } else if ((cb -= B_HIN) < B_HOUT) { if (!OUT0_I8) continue; W = I.hgrn_w_out; N = D; off = CSC_HOUT; }
        else if ((cb -= B_HOUT) < B_DIN) { W = I.diff_w_in; N = NP1; off = CSC_DIN; } else { cb -= B_DIN; W = I.diff_w_out; N = D; off = CSC_DOUT; }
        const float* p = W + (size_t)(ks * KR) * N + cb * 256 + 4 * lane; f32x4 m = {0.f, 0.f, 0.f, 0.f};
#pragma unroll 8
        for (int r = 0; r < KR; ++r) { const f32x4 x = __builtin_nontemporal_load((const f32x4*)(p + (size_t)r * N)); m[0] = fmaxf(m[0], fabsf(x[0])); m[1] = fmaxf(m[1], fabsf(x[1])); m[2] = fmaxf(m[2], fabsf(x[2])); m[3] = fmaxf(m[3], fabsf(x[3])); }
#pragma unroll
        for (int j = 0; j < 4; ++j) atomicMax(cm + off + cb * 256 + 4 * lane + j, __float_as_uint(m[j]));
    }
}
__device__ __forceinline__ void norm_regs(const f32x4 (&vin)[8], bf16_t* __restrict__ xn, const float* __restrict__ gain, int lane, const int xn_mode, float* __restrict__ xn_scale) {
    f32x4 v[8]; float s = 0.f;
#pragma unroll
    for (int j = 0; j < 8; ++j) { v[j] = vin[j]; s += (v[j][0] * v[j][0] + v[j][1] * v[j][1]) + (v[j][2] * v[j][2] + v[j][3] * v[j][3]); }
    const float rstd = 1.0f / sqrtf(wave_sum(s) * (1.f / D) + NORM_EPS);
    if (xn_mode == 2) {
        float amax = 0.f;
#pragma unroll
        for (int j = 0; j < 8; ++j) { const f32x4 g = *((const f32x4*)gain + 64 * j + lane); v[j] = v[j] * rstd * g;
            amax = fmaxf(fmaxf(amax, fmaxf(fabsf(v[j][0]), fabsf(v[j][1]))), fmaxf(fabsf(v[j][2]), fabsf(v[j][3]))); }
#pragma unroll
        for (int o = 1; o < 64; o <<= 1) amax = fmaxf(amax, __shfl_xor(amax, o));
        const float inv = amax > 0.f ? 127.0f / amax : 0.f;
#pragma unroll
        for (int j = 0; j < 8; ++j) { const int q0 = (int)rintf(v[j][0] * inv), q1 = (int)rintf(v[j][1] * inv), q2 = (int)rintf(v[j][2] * inv), q3 = (int)rintf(v[j][3] * inv);
            *((unsigned*)xn + 64 * j + lane) = (unsigned)(q0 & 0xff) | ((unsigned)(q1 & 0xff) << 8) | ((unsigned)(q2 & 0xff) << 16) | ((unsigned)q3 << 24); }
        if (lane == 0) *xn_scale = amax * (1.0f / (127.0f * 127.0f));
    } else {
#pragma unroll
        for (int j = 0; j < 8; ++j) { const f32x4 g = *((const f32x4*)gain + 64 * j + lane);
            if (xn_mode == 1) { *((unsigned*)xn + 64 * j + lane) = pk4_fp8(v[j][0] * rstd * g[0], v[j][1] * rstd * g[1], v[j][2] * rstd * g[2], v[j][3] * rstd * g[3]); }
            else { u32x2 o; o.x = cvt_pk_bf16(v[j][0] * rstd * g[0], v[j][1] * rstd * g[1]); o.y = cvt_pk_bf16(v[j][2] * rstd * g[2], v[j][3] * rstd * g[3]); *((u32x2*)xn + 64 * j + lane) = o; } } }
}
template <bool X_BF16, bool H_BF16>
__device__ __forceinline__ void norm_row(const void* __restrict__ xrow, const void* __restrict__ ya, const void* __restrict__ yb, float w0, float w1,
                                         void* __restrict__ hout, bf16_t* __restrict__ xn, const float* __restrict__ gain, int lane, const int xn_mode  , float* __restrict__ xn_scale) {
    f32x4 v[8]; float s = 0.f;
#pragma unroll
    for (int j = 0; j < 8; ++j) {
        if constexpr (X_BF16) { const u32x2 q = *((const u32x2*)xrow + 64 * j + lane); v[j] = (f32x4){bf_lo(q.x), bf_hi(q.x), bf_lo(q.y), bf_hi(q.y)}; }
        else v[j] = *((const f32x4*)xrow + 64 * j + lane);
        if (ya) {
#if Y_FP8
            const f32x4 a = unpk4_fp8(*((const unsigned*)ya + 64 * j + lane)), b = unpk4_fp8(*((const unsigned*)yb + 64 * j + lane));
            v[j] += w0 * a + w1 * b;
#else
            const u32x2 a = *((const u32x2*)ya + 64 * j + lane), b = *((const u32x2*)yb + 64 * j + lane);
            v[j][0] += w0 * bf_lo(a.x) + w1 * bf_lo(b.x); v[j][1] += w0 * bf_hi(a.x) + w1 * bf_hi(b.x); v[j][2] += w0 * bf_lo(a.y) + w1 * bf_lo(b.y); v[j][3] += w0 * bf_hi(a.y) + w1 * bf_hi(b.y);
#endif
        }
        if constexpr (H_BF16) {
            if (hout) { u32x2 o; o.x = cvt_pk_bf16(v[j][0], v[j][1]); o.y = cvt_pk_bf16(v[j][2], v[j][3]); *((u32x2*)hout + 64 * j + lane) = o; v[j] = (f32x4){bf_lo(o.x), bf_hi(o.x), bf_lo(o.y), bf_hi(o.y)}; } }
        s += (v[j][0] * v[j][0] + v[j][1] * v[j][1]) + (v[j][2] * v[j][2] + v[j][3] * v[j][3]); }
    if constexpr (!H_BF16) { if (hout) {
#pragma unroll
        for (int j = 0; j < 8; ++j) *((f32x4*)hout + 64 * j + lane) = v[j]; } }
    if (xn) {
        const float rstd = 1.0f / sqrtf(wave_sum(s) * (1.f / D) + NORM_EPS);
        if (xn_mode == 2) {
            float amax = 0.f;
#pragma unroll
            for (int j = 0; j < 8; ++j) { const f32x4 g = *((const f32x4*)gain + 64 * j + lane); v[j] = v[j] * rstd * g;
                amax = fmaxf(fmaxf(amax, fmaxf(fabsf(v[j][0]), fabsf(v[j][1]))), fmaxf(fabsf(v[j][2]), fabsf(v[j][3]))); }
#pragma unroll
            for (int o = 1; o < 64; o <<= 1) amax = fmaxf(amax, __shfl_xor(amax, o));
            const float inv = amax > 0.f ? 127.0f / amax : 0.f;
#pragma unroll
            for (int j = 0; j < 8; ++j) { const int q0 = (int)rintf(v[j][0] * inv), q1 = (int)rintf(v[j][1] * inv), q2 = (int)rintf(v[j][2] * inv), q3 = (int)rintf(v[j][3] * inv);
                *((unsigned*)xn + 64 * j + lane) = (unsigned)(q0 & 0xff) | ((unsigned)(q1 & 0xff) << 8) | ((unsigned)(q2 & 0xff) << 16) | ((unsigned)q3 << 24); }
            if (lane == 0) *xn_scale = amax * (1.0f / (127.0f * 127.0f));
        } else {
#pragma unroll
        for (int j = 0; j < 8; ++j) { const f32x4 g = *((const f32x4*)gain + 64 * j + lane);
            if (xn_mode == 1) { *((unsigned*)xn + 64 * j + lane) = pk4_fp8(v[j][0] * rstd * g[0], v[j][1] * rstd * g[1], v[j][2] * rstd * g[2], v[j][3] * rstd * g[3]); }
            else { u32x2 o; o.x = cvt_pk_bf16(v[j][0] * rstd * g[0], v[j][1] * rstd * g[1]); o.y = cvt_pk_bf16(v[j][2] * rstd * g[2], v[j][3] * rstd * g[3]);
                   *((u32x2*)xn + 64 * j + lane) = o; } } } }
}

__device__ __forceinline__ void p0_prologue(Frame& F) {
    const CAS Inputs& I = kargs()->in;
    LAS unsigned* scr = (LAS unsigned*)(F.lds + F.wave * 16384);
    const int gw = F.vcu * NWAVES + F.wave, NGW = F.G * NWAVES;
    unsigned char* ws = F.ws();
    if (INPROJ_MODE == 2) colmax_phase(F);
    { bf16_t* wrt = (bf16_t*)(ws + WS_WRT);
      const int gt = F.vcu * NTHR + F.tid(), NGT = F.G * NTHR;
      for (int i = gt; i < 2 * NRT * D; i += NGT) { const int l = i / (NRT * D), r2 = i % (NRT * D), n = r2 / D, k = r2 % D;
          float w = 0.f; if (n < 8) w = I.moe_w_group[((size_t)l * D + k) * 8 + n]; else if (n < 72) w = I.moe_w_expert[((size_t)l * D + k) * 64 + (n - 8)];
          const _Float16 wh = (_Float16)w;
          wrt[((size_t)(l * 2 + 0) * NRT + n) * D + k] = __builtin_bit_cast(bf16_t, wh); }
      float* rc = (float*)(ws + WS_ROPE); float* rs = rc + (size_t)M * 64;
      for (int i = gt; i < M * 64; i += NGT) { const int t = i >> 6, f = i & 63; const float inv = exp2f(-(float)f * (13.287712379549449f / 64.f)); const float ang = (float)I.positions[t] * inv;
          float rev = ang * 0.15915494309189535f; rev -= rintf(rev);
          rc[i] = __builtin_amdgcn_cosf(rev); rs[i] = __builtin_amdgcn_sinf(rev); }
    }
    { f32x4 xr[8], xnx[8]; const int lane = F.lane();
      if (gw < M) {
#pragma unroll
          for (int j = 0; j < 8; ++j) xr[j] = __builtin_nontemporal_load((const f32x4*)(I.x + (size_t)gw * D) + 64 * j + lane); }
      for (int m = gw; m < M; m += NGW) {
          if (m + NGW < M) {
#pragma unroll
              for (int j = 0; j < 8; ++j) xnx[j] = __builtin_nontemporal_load((const f32x4*)(I.x + (size_t)(m + NGW) * D) + 64 * j + lane); }
          norm_regs(xr, (bf16_t*)(ws + WS_XN + (size_t)m * D * INPROJ_ESZ), I.mix_norm, lane, INPROJ_MODE, (float*)(ws + WS_XNS) + m);
#pragma unroll
          for (int j = 0; j < 8; ++j) xr[j] = xnx[j]; } }
}

constexpr int HG_C = 32;
constexpr int HQ_P = 136, HK_P = 40, HO_P = 132;
constexpr int HL_QD = 0, HL_KI = HL_QD + HG_C * HQ_P * 2, HL_KET = HL_KI + HG_C * HQ_P * 2, HL_VT = HL_KET + 128 * HK_P * 2, HL_DEC = HL_VT + 128 * HK_P * 2, HL_SET = HL_DEC + 512;
constexpr int HL_OT = 2 * HL_SET, HL_OTB = HG_C * HO_P * 4, HL_END = HL_OT + 4 * HL_OTB;
static_assert(HL_END <= RING_BYTES && HL_SET % 16 == 0, "hgrn LDS");
#ifndef HG_REP
#define HG_REP 1
#endif
#ifndef HG_CONV_CUT
#define P0B_CUT 50
#define HG_CONV_CUT 88
#endif
__device__ __forceinline__ bf16x8 pack_acc8(const f32x16& x, int s) {
    u32x4 p; p.x = cvt_pk_bf16(x[8 * s + 0], x[8 * s + 1]); p.y = cvt_pk_bf16(x[8 * s + 2], x[8 * s + 3]); p.z = cvt_pk_bf16(x[8 * s + 4], x[8 * s + 5]); p.w = cvt_pk_bf16(x[8 * s + 6], x[8 * s + 7]);
    return __builtin_bit_cast(bf16x8, p);
}
__device__ __forceinline__ bf16x8 ld2x8(const LAS unsigned char* p0, const LAS unsigned char* p1) {
    const s16x4 a = *(const LAS s16x4*)p0, b = *(const LAS s16x4*)p1; return __builtin_shufflevector(a, b, 0, 1, 2, 3, 4, 5, 6, 7);
}
__device__ __forceinline__ void hgrn_phase(Frame& F) {
    const CAS Inputs& I = kargs()->in;
    LAS unsigned char* L = F.lds;
    const int tid = F.tid(), lane = F.lane(), w = F.wave;
    if (F.vcu & 1) {
        if (P0B_CUT < 100) convert_weights(F, 0, (F.vcu >> 1) * NWAVES + F.wave, (F.G >> 1) * NWAVES, (LAS unsigned*)(F.lds + F.wave * 16384), P0B_CUT, 100);
        convert_weights(F, 1, (F.vcu >> 1) * NWAVES + F.wave, (F.G >> 1) * NWAVES, (LAS unsigned*)(F.lds + F.wave * 16384), 0, HG_CONV_CUT);
        return; }
    const bf16_t* PROJ = (const bf16_t*)(F.ws() + WS_PROJ); bf16_t* MIX = (bf16_t*)(F.ws() + WS_MIX);
    for (int rep2 = 0; rep2 < HG_REP; ++rep2)
    for (int p = F.vcu >> 1; p < BATCH * HG_H; p += (F.G >> 1)) {
        const int b = p / HG_H, h = p % HG_H;
        const int ch = 16 * w + (lane >> 2), seg = lane & 3;
        float lb;
        { const float l0 = I.hgrn_lb[h * 128 + ch], l1 = I.hgrn_lb[D + h * 128 + ch], l2 = I.hgrn_lb[2 * D + h * 128 + ch]; const float mx = fmaxf(l0, fmaxf(l1, l2));
          const float e0 = expf(l0 - mx), e1 = expf(l1 - mx), e2 = expf(l2 - mx); lb = e0 / (e0 + e1 + e2); }
        const float omlb = 1.0f - lb;
        const int vb = w & 3, kh = w >> 2, r = lane & 31, hh = lane >> 5;
        const int c4 = tid >> 4, vs = tid & 15;
        const f32x4 og0 = *(const f32x4*)(I.hgrn_out_gain + 8 * vs), og1 = *(const f32x4*)(I.hgrn_out_gain + 8 * vs + 4);
        f32x16 S0 = {}, S1 = {};
        unsigned rqA[8], rfA[8], rvA[8], rqB[8], rfB[8], rvB[8]; u32x4 rgA, rgB, g_cur, g_next;
        const bf16_t* prow = PROJ + (size_t)(b * SEQ + 8 * seg) * NP0 + h * 128 + ch;
        const bf16_t* grow = PROJ + (size_t)(b * SEQ + c4) * NP0 + 3 * D + h * 128 + 8 * vs;
#define HG_PREFETCH(n_, S) do { const bf16_t* pr_ = prow + (size_t)(n_) * HG_C * NP0; _Pragma("unroll") for (int i = 0; i < 8; ++i) { rq##S[i] = (unsigned)__builtin_nontemporal_load(pr_ + (size_t)i * NP0); rf##S[i] = (unsigned)__builtin_nontemporal_load(pr_ + (size_t)i * NP0 + D); rv##S[i] = (unsigned)__builtin_nontemporal_load(pr_ + (size_t)i * NP0 + 2 * D); } \
        rg##S = __builtin_nontemporal_load((const u32x4*)(grow + (size_t)(n_) * HG_C * NP0)); } while (0)
#define HG_ELEM(T_, S) do { float qv[8], kk[8], cl[8]; float run = 1.f; \
            _Pragma("unroll") for (int i = 0; i < 8; ++i) { qv[i] = __uint_as_float(rq##S[i] << 16); const float e_ = __expf(-__uint_as_float(rf##S[i] << 16)); const float sg_ = __builtin_amdgcn_rcpf(1.0f + e_); \
                kk[i] = omlb * e_ * sg_; run *= lb + omlb * sg_; cl[i] = run; } \
            float pre = 1.f, tot = 1.f; \
            _Pragma("unroll") for (int s2 = 0; s2 < 4; ++s2) { const float sv = __shfl(run, (lane & ~3) + s2); tot *= sv; if (s2 < seg) pre *= sv; } \
            unsigned ke[4], vp[4]; \
            _Pragma("unroll") for (int i = 0; i < 8; i += 2) { const float c0 = pre * cl[i], c1 = pre * cl[i + 1]; const float i0 = __builtin_amdgcn_rcpf(c0), i1 = __builtin_amdgcn_rcpf(c1); \
                ((LAS bf16_t*)((T_) + HL_QD))[(8 * seg + i) * HQ_P + ch] = (bf16_t)(cvt_pk_bf16(qv[i] * c0, 0.f) & 0xffffu); ((LAS bf16_t*)((T_) + HL_QD))[(8 * seg + i + 1) * HQ_P + ch] = (bf16_t)(cvt_pk_bf16(qv[i + 1] * c1, 0.f) & 0xffffu); \
                ((LAS bf16_t*)((T_) + HL_KI))[(8 * seg + i) * HQ_P + ch] = (bf16_t)(cvt_pk_bf16(kk[i] * i0, 0.f) & 0xffffu); ((LAS bf16_t*)((T_) + HL_KI))[(8 * seg + i + 1) * HQ_P + ch] = (bf16_t)(cvt_pk_bf16(kk[i + 1] * i1, 0.f) & 0xffffu); \
                ke[i >> 1] = cvt_pk_bf16(kk[i] * tot * i0, kk[i + 1] * tot * i1); vp[i >> 1] = rv##S[i] | (rv##S[i + 1] << 16); } \
            *(LAS u32x4*)((T_) + HL_KET + (ch * HK_P + 8 * seg) * 2) = (u32x4){ke[0], ke[1], ke[2], ke[3]}; \
            *(LAS u32x4*)((T_) + HL_VT + (ch * HK_P + 8 * seg) * 2) = (u32x4){vp[0], vp[1], vp[2], vp[3]}; \
            if (seg == 0) ((LAS float*)((T_) + HL_DEC))[ch] = tot; } while (0)
        HG_PREFETCH(0, A); HG_PREFETCH(1, B);
        HG_ELEM(L, A); g_cur = rgA;
        HG_PREFETCH(2, A);
        __syncthreads();
#pragma unroll 2
        for (int n = 0; n < SEQ / HG_C; ++n) {
            const int t0 = b * SEQ + n * HG_C;
            LAS unsigned char* T = L + (n & 1) * HL_SET;
            LAS unsigned char* OTn = L + HL_OT + (n & 1) * 2 * HL_OTB;
            f32x16 oacc = {};
            if (kh == 0) {
                f32x16 X = {};
#pragma unroll
                for (int ks = 0; ks < 8; ++ks) { const bf16x8 a = *(const LAS bf16x8*)(T + HL_KI + (r * HQ_P + 16 * ks + 8 * hh) * 2), bq = *(const LAS bf16x8*)(T + HL_QD + (r * HQ_P + 16 * ks + 8 * hh) * 2);
                    X = __builtin_amdgcn_mfma_f32_32x32x16_bf16(a, bq, X, 0, 0, 0); }
#pragma unroll
                for (int i = 0; i < 16; ++i) { const int d = (i & 3) + 8 * (i >> 2) + 4 * hh; if (d > r) X[i] = 0.f; }
#pragma unroll
                for (int s = 0; s < 2; ++s) { const bf16x8 xs = pack_acc8(X, s);
                    const LAS unsigned char* vrow = T + HL_VT + ((32 * vb + r) * HK_P + 16 * s + 4 * hh) * 2;
                    oacc = __builtin_amdgcn_mfma_f32_32x32x16_bf16(xs, ld2x8(vrow, vrow + 16), oacc, 0, 0, 0); }
            }
#pragma unroll
            for (int q2 = 0; q2 < 2; ++q2) { const int kb = 2 * kh + q2;
#pragma unroll
                for (int s = 0; s < 2; ++s) { const bf16x8 xs = pack_acc8(q2 == 0 ? S0 : S1, s);
                    const LAS unsigned char* qrow = T + HL_QD + (r * HQ_P + 32 * kb + 16 * s + 4 * hh) * 2;
                    oacc = __builtin_amdgcn_mfma_f32_32x32x16_bf16(ld2x8(qrow, qrow + 16), xs, oacc, 0, 0, 0); } }
            { LAS float* OTw = (LAS float*)(OTn + kh * HL_OTB);
#pragma unroll
              for (int i = 0; i < 16; ++i) OTw[((i & 3) + 8 * (i >> 2) + 4 * hh) * HO_P + 32 * vb + r] = oacc[i]; }
#pragma unroll
            for (int q2 = 0; q2 < 2; ++q2) { const int kb = 2 * kh + q2; f32x16 Sx = q2 == 0 ? S0 : S1;
#pragma unroll
                for (int i = 0; i < 16; ++i) Sx[i] *= ((LAS float*)(T + HL_DEC))[32 * kb + (i & 3) + 8 * (i >> 2) + 4 * hh];
#pragma unroll
                for (int s = 0; s < 2; ++s) { const bf16x8 a = *(const LAS bf16x8*)(T + HL_KET + ((32 * kb + r) * HK_P + 16 * s + 8 * hh) * 2), bv = *(const LAS bf16x8*)(T + HL_VT + ((32 * vb + r) * HK_P + 16 * s + 8 * hh) * 2);
                    Sx = __builtin_amdgcn_mfma_f32_32x32x16_bf16(a, bv, Sx, 0, 0, 0); }
                if (q2 == 0) S0 = Sx; else S1 = Sx; }
            if (n + 1 < SEQ / HG_C) { LAS unsigned char* Tn = L + ((n + 1) & 1) * HL_SET;
                if ((n + 1) & 1) { HG_ELEM(Tn, B); g_next = rgB; if (n + 3 < SEQ / HG_C) HG_PREFETCH(n + 3, B); }
                else             { HG_ELEM(Tn, A); g_next = rgA; if (n + 3 < SEQ / HG_C) HG_PREFETCH(n + 3, A); } }
            __syncthreads();
            { const LAS float* O0 = (const LAS float*)OTn + c4 * HO_P + 8 * vs; const LAS float* O1 = (const LAS float*)(OTn + HL_OTB) + c4 * HO_P + 8 * vs;
              const f32x4 a = *(const LAS f32x4*)O0 + *(const LAS f32x4*)O1, bq = *(const LAS f32x4*)(O0 + 4) + *(const LAS f32x4*)(O1 + 4);
              float ss = (a[0] * a[0] + a[1] * a[1]) + (a[2] * a[2] + a[3] * a[3]) + (bq[0] * bq[0] + bq[1] * bq[1]) + (bq[2] * bq[2] + bq[3] * bq[3]);
              ss += __shfl_xor(ss, 1); ss += __shfl_xor(ss, 2); ss += __shfl_xor(ss, 4); ss += __shfl_xor(ss, 8);
              const float rstd = 1.0f / sqrtf(ss * (1.f / 128.f) + NORM_EPS);
              const u32x4 gq = g_cur;
              const float y0 = a[0] * rstd * og0[0] * bf_lo(gq.x), y1 = a[1] * rstd * og0[1] * bf_hi(gq.x), y2 = a[2] * rstd * og0[2] * bf_lo(gq.y), y3 = a[3] * rstd * og0[3] * bf_hi(gq.y);
              const float y4 = bq[0] * rstd * og1[0] * bf_lo(gq.z), y5 = bq[1] * rstd * og1[1] * bf_hi(gq.z), y6 = bq[2] * rstd * og1[2] * bf_lo(gq.w), y7 = bq[3] * rstd * og1[3] * bf_hi(gq.w);
#if FP8_OUTPROJ
              u32x2 o; o.x = pk4_fp8(y0, y1, y2, y3); o.y = pk4_fp8(y4, y5, y6, y7);
              *(u32x2*)((unsigned char*)MIX + (size_t)(t0 + c4) * D + h * 128 + 8 * vs) = o; }
#else
              u32x4 o; o.x = cvt_pk_bf16(y0, y1); o.y = cvt_pk_bf16(y2, y3); o.z = cvt_pk_bf16(y4, y5); o.w = cvt_pk_bf16(y6, y7);
              *(u32x4*)(MIX + (size_t)(t0 + c4) * D + h * 128 + 8 * vs) = o; }
#endif
            g_cur = g_next;
        }
#undef HG_PREFETCH
#undef HG_ELEM
        __syncthreads();
    }
    convert_weights(F, 1, (F.vcu >> 1) * NWAVES + F.wave, (F.G >> 1) * NWAVES, (LAS unsigned*)(F.lds + F.wave * 16384), HG_CONV_CUT, 100);
}

constexpr int RL_GN = 0, RL_W = 8192, RW_P = 136, RW_ONE = NRT * RW_P * 2, RL_PL = RL_W, RL_SS = RL_PL + 2 * 4 * 16 * NRT * 4, RL_END = RL_W + 4 * RW_ONE;
static_assert(RL_SS + 2 * 4 * 16 * 4 <= RL_END && RL_END <= RING_BYTES, "router LDS");
__device__ __forceinline__ void router_phase(Frame& F, const bf16_t* __restrict__ Hres, const float* __restrict__ gain, int layer) {
    LAS unsigned char* L = F.lds;
    const int tid = F.tid(), lane = F.lane(), w = F.wave, g = w & 3, kh = w >> 2, r16 = lane & 15, kg = lane >> 4;
    const bf16_t* wrt = (const bf16_t*)(F.ws() + WS_WRT) + (size_t)(layer * 2) * NRT * D;
    bf16_t* XF = (bf16_t*)(F.ws() + WS_XF);
    int* tok_e = (int*)(F.ws() + WS_TOKE); float* tok_w = (float*)(F.ws() + WS_TOKW); int* tok_p = (int*)(F.ws() + WS_TOKP); float* rstd_t = (float*)(F.ws() + WS_RSTDT);
    unsigned* cnt = F.ctl() + CW_CNT + layer * 1024;
    for (int blk = F.vcu; blk < M / 64; blk += F.G) {
        __syncthreads();
        for (int i = tid; i < D / 4; i += NTHR) ((LAS f32x4*)(L + RL_GN))[i] = ((const f32x4*)gain)[i];
        const int t = blk * 64 + 16 * g + r16;
        f32x4 acc[5];
#pragma unroll
        for (int i = 0; i < 5; ++i) acc[i] = (f32x4){0.f, 0.f, 0.f, 0.f};
        float ss = 0.f;
        const bf16_t* hrow = Hres + (size_t)t * D + 1024 * kh + 8 * kg;
        unsigned char* xrow = (unsigned char*)XF + ((size_t)t * D + 1024 * kh + 8 * kg) * (FP8_MOE ? 1 : 2);
        u32x4 wsA[5], wsB[5]; u32x4 haA[4], haB[4], hb[4];
#define RT_WLOAD(b_, S) do { _Pragma("unroll") for (int j = 0; j < 5; ++j) { const int c = tid + 512 * j, kc = c & 15, n = (c >> 4) % NRT, q = (c >> 4) / NRT; \
            ws##S[j] = *(const u32x4*)(wrt + (size_t)n * D + 1024 * q + 128 * (b_) + 8 * kc); } } while (0)
#define RT_WSTORE(S) do { _Pragma("unroll") for (int j = 0; j < 5; ++j) { const int c = tid + 512 * j, kc = c & 15, n = (c >> 4) % NRT, q = (c >> 4) / NRT; \
            *(LAS u32x4*)(L + RL_W + 2 * q * RW_ONE + (n * RW_P + 8 * kc) * 2) = ws##S[j]; } } while (0)
#define RT_ALOAD(b_, S) do { _Pragma("unroll") for (int s = 0; s < 4; ++s) ha##S[s] = *(const u32x4*)(hrow + 128 * (b_) + 32 * s); } while (0)
        RT_WLOAD(0, A); RT_ALOAD(0, A); RT_WLOAD(1, B); RT_ALOAD(1, B);
        for (int b = 0; b < 8; ++b) {
            __syncthreads();
            if (b & 1) { RT_WSTORE(B);
#pragma unroll
                for (int i = 0; i < 4; ++i) hb[i] = haB[i];
                if (b + 2 < 8) { RT_WLOAD(b + 2, B); RT_ALOAD(b + 2, B); } }
            else { RT_WSTORE(A);
#pragma unroll
                for (int i = 0; i < 4; ++i) hb[i] = haA[i];
                if (b + 2 < 8) { RT_WLOAD(b + 2, A); RT_ALOAD(b + 2, A); } }
            __syncthreads();
            const LAS unsigned char* Wh = L + RL_W + (kh * 2 + 0) * RW_ONE + (r16 * RW_P + 8 * kg) * 2;
#pragma unroll
            for (int s = 0; s < 4; ++s) {
                const f32x4 h0 = {bf_lo(hb[s].x), bf_hi(hb[s].x), bf_lo(hb[s].y), bf_hi(hb[s].y)}, h1 = {bf_lo(hb[s].z), bf_hi(hb[s].z), bf_lo(hb[s].w), bf_hi(hb[s].w)};
                const f32x4 g0 = *(const LAS f32x4*)(L + RL_GN + (1024 * kh + 128 * b + 32 * s + 8 * kg) * 4), g1 = *(const LAS f32x4*)(L + RL_GN + (1024 * kh + 128 * b + 32 * s + 8 * kg + 4) * 4);
                ss += (h0[0] * h0[0] + h0[1] * h0[1]) + (h0[2] * h0[2] + h0[3] * h0[3]) + (h1[0] * h1[0] + h1[1] * h1[1]) + (h1[2] * h1[2] + h1[3] * h1[3]);
                const f32x4 x0 = h0 * g0, x1 = h1 * g1;
                const f16x8 ah = {(_Float16)x0[0], (_Float16)x0[1], (_Float16)x0[2], (_Float16)x0[3], (_Float16)x1[0], (_Float16)x1[1], (_Float16)x1[2], (_Float16)x1[3]};
                { u32x2 f8; f8.x = pk4_fp8(x0[0], x0[1], x0[2], x0[3]); f8.y = pk4_fp8(x1[0], x1[1], x1[2], x1[3]); *(u32x2*)(xrow + 128 * b + 32 * s) = f8; }
#pragma unroll
                for (int nt = 0; nt < 5; ++nt) { const f16x8 bh = *(const LAS f16x8*)(Wh + (nt * 16 * RW_P + 32 * s) * 2);
                    acc[nt] = __builtin_amdgcn_mfma_f32_16x16x32_f16(ah, bh, acc[nt], 0, 0, 0); }
            }
        }
#undef RT_WLOAD
#undef RT_WSTORE
#undef RT_ALOAD
        __syncthreads();
        LAS float* PL = (LAS float*)(L + RL_PL) + (size_t)(kh * 4 + g) * 16 * NRT;
#pragma unroll
        for (int nt = 0; nt < 5; ++nt)
#pragma unroll
            for (int i = 0; i < 4; ++i) PL[(4 * kg + i) * NRT + 16 * nt + r16] = acc[nt][i];
        ss += __shfl_xor(ss, 16); ss += __shfl_xor(ss, 32);
        if (lane < 16) ((LAS float*)(L + RL_SS))[(kh * 4 + g) * 16 + lane] = ss;
        __syncthreads();
        if (F.tid() < 64) {
            const int tt = F.tid(), gg = tt >> 4, row = tt & 15, tk = blk * 64 + tt;
            const float s2 = ((LAS float*)(L + RL_SS))[gg * 16 + row] + ((LAS float*)(L + RL_SS))[(4 + gg) * 16 + row];
            const float rstd = 1.0f / sqrtf(s2 * (1.f / D) + NORM_EPS);
            const LAS float* p0 = (LAS float*)(L + RL_PL) + (size_t)(gg * 16 + row) * NRT; const LAS float* p1 = p0 + (size_t)4 * 16 * NRT;
            float gm = -3.0e38f; int gi = 0; float gl[8];
#pragma unroll
            for (int j = 0; j < 8; ++j) { gl[j] = rstd * (p0[j] + p1[j]); if (gl[j] > gm) { gm = gl[j]; gi = j; } }
            float gs = 0.f;
#pragma unroll
            for (int j = 0; j < 8; ++j) gs += expf(gl[j] - gm);
            const float gp = 1.0f / gs;
            float m1 = -3.0e38f, m2 = -3.0e38f; int i1 = 0, i2 = 0;
#pragma unroll
            for (int j = 0; j < 8; ++j) { const float v = rstd * (p0[8 + 8 * gi + j] + p1[8 + 8 * gi + j]);
                if (v > m1) { m2 = m1; i2 = i1; m1 = v; i1 = j; } else if (v > m2) { m2 = v; i2 = j; } }
            const float rr = expf(m2 - m1); const float w1 = gp / (1.0f + rr), w2 = gp * rr / (1.0f + rr);
            const int e1 = gi * 8 + i1, e2 = gi * 8 + i2;
            const int q1 = (int)atomicAdd(cnt + e1 * 16, 1u), q2 = (int)atomicAdd(cnt + e2 * 16, 1u);
            { int2* list = (int2*)(F.ws() + WS_LIST); list[(size_t)e1 * M + q1] = make_int2(tk, __float_as_int(rstd)); list[(size_t)e2 * M + q2] = make_int2(tk, __float_as_int(rstd)); }
            tok_e[2 * tk] = e1; tok_e[2 * tk + 1] = e2; tok_w[2 * tk] = w1; tok_w[2 * tk + 1] = w2; tok_p[2 * tk] = q1; tok_p[2 * tk + 1] = q2; rstd_t[tk] = rstd;
        }
        __syncthreads();
    }
}
__device__ __forceinline__ int moe_tables(Frame& F, int layer) {
    LAS int* est = (LAS int*)(F.lds + TAB_OFF); LAS int* tile_e = est + 72;
    __syncthreads();
    if (F.wave == 0) {
        const int e = F.lane(); const unsigned* cnt = F.ctl() + CW_CNT + layer * 1024;
        const int c = (int)__hip_atomic_load(cnt + e * 16, __ATOMIC_RELAXED, __HIP_MEMORY_SCOPE_AGENT); const int nt = (c + 255) >> 8;
        int incl = nt;
#pragma unroll
        for (int o = 1; o < 64; o <<= 1) { const int v = __shfl_up(incl, o); if (e >= o) incl += v; }
        const int t0 = incl - nt;
        est[e] = t0 << 8; est[72 + 192 + e] = c; if (e == NE - 1) est[NE] = incl << 8;
        for (int k = 0; k < nt; ++k) tile_e[t0 + k] = e; }
    __syncthreads();
    return est[NE] >> 8;
}
__device__ __forceinline__ void scatter_phase(Frame& F, int layer) {
    (void)moe_tables(F, layer);
    const LAS int* est = (const LAS int*)(F.lds + TAB_OFF);
    const int gt = F.vcu * NTHR + F.tid(), NGT = F.G * NTHR;
    const int* tok_e = (const int*)(F.ws() + WS_TOKE); const int* tok_p = (const int*)(F.ws() + WS_TOKP); int* tok_r = (int*)(F.ws() + WS_TOKR); int* row_tok = (int*)(F.ws() + WS_ROWT);
    const float* rstd_t = (const float*)(F.ws() + WS_RSTDT); float* rstd_r = (float*)(F.ws() + WS_RSTDR);
    for (int t = gt; t < M; t += NGT) {
        const int e0 = tok_e[2 * t], e1 = tok_e[2 * t + 1]; const int r0 = est[e0] + tok_p[2 * t], r1 = est[e1] + tok_p[2 * t + 1];
        tok_r[2 * t] = r0; tok_r[2 * t + 1] = r1; row_tok[r0] = t; row_tok[r1] = t; const float rs = rstd_t[t]; rstd_r[r0] = rs; rstd_r[r1] = rs; }
    if (F.vcu < NE) {
        const int e = F.vcu; const unsigned* cnt = F.ctl() + CW_CNT + layer * 1024;
        const int c = (int)__hip_atomic_load(cnt + e * 16, __ATOMIC_RELAXED, __HIP_MEMORY_SCOPE_AGENT);
        for (int r = est[e] + c + F.tid(); r < est[e + 1]; r += NTHR) { row_tok[r] = 0; rstd_r[r] = 0.f; } }
}
struct CombRaw { u32x2 h[8]; u32x2 ya2[8], yb2[8]; unsigned ya[8], yb[8]; };
__device__ __forceinline__ void comb_load(CombRaw& R, const bf16_t* xrow, const unsigned char* ya, const unsigned char* yb, int lane) {
#pragma unroll
    for (int j = 0; j < 8; ++j) { R.h[j] = __builtin_nontemporal_load((const u32x2*)xrow + 64 * j + lane);
#if Y_FP8
        R.ya[j] = __builtin_nontemporal_load((const unsigned*)ya + 64 * j + lane); R.yb[j] = __builtin_nontemporal_load((const unsigned*)yb + 64 * j + lane);
#else
        R.ya2[j] = *((const u32x2*)ya + 64 * j + lane); R.yb2[j] = *((const u32x2*)yb + 64 * j + lane);
#endif
    }
}
template <bool LAST>
__device__ __forceinline__ void comb_finish(const CombRaw& R, float w0, float w1, void* __restrict__ hout, bf16_t* __restrict__ xn, const float* __restrict__ gain, int lane, float* __restrict__ xn_scale) {
    f32x4 v[8]; float s = 0.f;
#pragma unroll
    for (int j = 0; j < 8; ++j) { v[j] = (f32x4){bf_lo(R.h[j].x), bf_hi(R.h[j].x), bf_lo(R.h[j].y), bf_hi(R.h[j].y)};
#if Y_FP8
        v[j] += w0 * unpk4_fp8(R.ya[j]) + w1 * unpk4_fp8(R.yb[j]);
#else
        v[j][0] += w0 * bf_lo(R.ya2[j].x) + w1 * bf_lo(R.yb2[j].x); v[j][1] += w0 * bf_hi(R.ya2[j].x) + w1 * bf_hi(R.yb2[j].x); v[j][2] += w0 * bf_lo(R.ya2[j].y) + w1 * bf_lo(R.yb2[j].y); v[j][3] += w0 * bf_hi(R.ya2[j].y) + w1 * bf_hi(R.yb2[j].y);
#endif
        if constexpr (LAST) __builtin_nontemporal_store(v[j], (f32x4*)hout + 64 * j + lane);
        else { u32x2 o; o.x = cvt_pk_bf16(v[j][0], v[j][1]); o.y = cvt_pk_bf16(v[j][2], v[j][3]); *((u32x2*)hout + 64 * j + lane) = o; v[j] = (f32x4){bf_lo(o.x), bf_hi(o.x), bf_lo(o.y), bf_hi(o.y)};
               s += (v[j][0] * v[j][0] + v[j][1] * v[j][1]) + (v[j][2] * v[j][2] + v[j][3] * v[j][3]); } }
    if constexpr (!LAST) {
        const float rstd = 1.0f / sqrtf(wave_sum(s) * (1.f / D) + NORM_EPS);
        if (INPROJ_MODE == 2) {
            float amax = 0.f;
#pragma unroll
            for (int j = 0; j < 8; ++j) { const f32x4 g = *((const f32x4*)gain + 64 * j + lane); v[j] = v[j] * rstd * g;
                amax = fmaxf(fmaxf(amax, fmaxf(fabsf(v[j][0]), fabsf(v[j][1]))), fmaxf(fabsf(v[j][2]), fabsf(v[j][3]))); }
#pragma unroll
            for (int o = 1; o < 64; o <<= 1) amax = fmaxf(amax, __shfl_xor(amax, o));
            const float inv = amax > 0.f ? 127.0f / amax : 0.f;
#pragma unroll
            for (int j = 0; j < 8; ++j) { const int q0 = (int)rintf(v[j][0] * inv), q1 = (int)rintf(v[j][1] * inv), q2 = (int)rintf(v[j][2] * inv), q3 = (int)rintf(v[j][3] * inv);
                *((unsigned*)xn + 64 * j + lane) = (unsigned)(q0 & 0xff) | ((unsigned)(q1 & 0xff) << 8) | ((unsigned)(q2 & 0xff) << 16) | ((unsigned)q3 << 24); }
            if (lane == 0) *xn_scale = amax * (1.0f / (127.0f * 127.0f));
        } else {
#pragma unroll
            for (int j = 0; j < 8; ++j) { const f32x4 g = *((const f32x4*)gain + 64 * j + lane);
                if (INPROJ_MODE == 1) { *((unsigned*)xn + 64 * j + lane) = pk4_fp8(v[j][0] * rstd * g[0], v[j][1] * rstd * g[1], v[j][2] * rstd * g[2], v[j][3] * rstd * g[3]); }
                else { u32x2 o; o.x = cvt_pk_bf16(v[j][0] * rstd * g[0], v[j][1] * rstd * g[1]); o.y = cvt_pk_bf16(v[j][2] * rstd * g[2], v[j][3] * rstd * g[3]); *((u32x2*)xn + 64 * j + lane) = o; } } } }
}
template <bool LAST>
__device__ __forceinline__ void combine_phase(Frame& F, const bf16_t* __restrict__ hin, void* __restrict__ hout, bf16_t* xn, const float* gain, int layer) {
    (void)moe_tables(F, layer);
    const int gw = F.vcu * NWAVES + F.wave, NGW = F.G * NWAVES, lane = F.lane();
    const int* tok_e = (const int*)(F.ws() + WS_TOKE); const int* tok_p = (const int*)(F.ws() + WS_TOKP); const float* tok_w = (const float*)(F.ws() + WS_TOKW); const unsigned char* Y = (const unsigned char*)(F.ws() + WS_Y);
    const LAS int* est = (const LAS int*)(F.lds + TAB_OFF);
    constexpr size_t YB = (size_t)D * (Y_FP8 ? 1 : 2);
    constexpr int NT_ = M / (256 * NWAVES);
    int r0v[NT_], r1v[NT_]; float w0v[NT_], w1v[NT_];
#pragma unroll
    for (int k = 0; k < NT_; ++k) { const int t = gw + k * NGW; const bool ok = t < M; const int tt = ok ? t : 0;
        r0v[k] = est[tok_e[2 * tt]] + tok_p[2 * tt]; r1v[k] = est[tok_e[2 * tt + 1]] + tok_p[2 * tt + 1]; w0v[k] = tok_w[2 * tt]; w1v[k] = tok_w[2 * tt + 1]; }
    CombRaw RA, RB;
    if (gw < M) comb_load(RA, hin + (size_t)gw * D, Y + (size_t)r0v[0] * YB, Y + (size_t)r1v[0] * YB, lane);
#pragma unroll
    for (int k = 0; k < NT_; ++k) { const int t = gw + k * NGW; if (t >= M) break;
        const int tn = t + NGW; const bool hn = (k + 1 < NT_) && tn < M;
        CombRaw& cur = (k & 1) ? RB : RA; CombRaw& nxt = (k & 1) ? RA : RB;
        if (hn) comb_load(nxt, hin + (size_t)tn * D, Y + (size_t)r0v[k + 1] * YB, Y + (size_t)r1v[k + 1] * YB, lane);
        if constexpr (LAST) comb_finish<true>(cur, w0v[k], w1v[k], (float*)hout + (size_t)t * D, nullptr, gain, lane, nullptr);
        else comb_finish<false>(cur, w0v[k], w1v[k], (bf16_t*)hout + (size_t)t * D, (bf16_t*)((unsigned char*)xn + (size_t)t * D * INPROJ_ESZ), gain, lane, (float*)(F.ws() + WS_XNS) + t);
    }
    if (F.G != 256) {
        for (int t = gw + NT_ * NGW; t < M; t += NGW) { CombRaw R; const int r0 = est[tok_e[2 * t]] + tok_p[2 * t], r1 = est[tok_e[2 * t + 1]] + tok_p[2 * t + 1];
            comb_load(R, hin + (size_t)t * D, Y + (size_t)r0 * YB, Y + (size_t)r1 * YB, lane);
            if constexpr (LAST) comb_finish<true>(R, tok_w[2 * t], tok_w[2 * t + 1], (float*)hout + (size_t)t * D, nullptr, gain, lane, nullptr);
            else comb_finish<false>(R, tok_w[2 * t], tok_w[2 * t + 1], (bf16_t*)hout + (size_t)t * D, (bf16_t*)((unsigned char*)xn + (size_t)t * D * INPROJ_ESZ), gain, lane, (float*)(F.ws() + WS_XNS) + t); } }
}
__device__ __forceinline__ void qknorm_rope_phase(Frame& F) {
    const CAS Inputs& I = kargs()->in;
    const int gw = F.vcu * NWAVES + F.wave, NGW = F.G * NWAVES, l16 = F.lane() & 15, hq = F.lane() >> 4;
    bf16_t* QKV = (bf16_t*)(F.ws() + WS_PROJ); const float* rc = (const float*)(F.ws() + WS_ROPE); const float* rs = rc + (size_t)M * 64;
    for (int t = gw; t < M; t += NGW) {
        const f32x4 cs = *(const f32x4*)(rc + (size_t)t * 64 + 4 * l16), sn = *(const f32x4*)(rs + (size_t)t * 64 + 4 * l16);
#pragma unroll
        for (int it = 0; it < 8; ++it) { const int head = it * 4 + hq;
            bf16_t* p = QKV + (size_t)t * NP1 + head * 128 + 4 * l16;
            const u32x2 a = *(const u32x2*)p, b = *(const u32x2*)(p + 64);
            float x1[4] = {bf_lo(a.x), bf_hi(a.x), bf_lo(a.y), bf_hi(a.y)}, x2[4] = {bf_lo(b.x), bf_hi(b.x), bf_lo(b.y), bf_hi(b.y)};
            float ss = 0.f;
#pragma unroll
            for (int j = 0; j < 4; ++j) ss += x1[j] * x1[j] + x2[j] * x2[j];
            ss += __shfl_xor(ss, 1); ss += __shfl_xor(ss, 2); ss += __shfl_xor(ss, 4); ss += __shfl_xor(ss, 8);
            const float rstd = 1.0f / sqrtf(ss * (1.f / 128.f) + NORM_EPS);
            const float* gn = (head < 16 ? I.diff_q_gain : I.diff_k_gain) + 4 * l16;
            const f32x4 ga = *(const f32x4*)gn, gb = *(const f32x4*)(gn + 64);
            float o1[4], o2[4];
#pragma unroll
            for (int j = 0; j < 4; ++j) { const float y1 = x1[j] * rstd * ga[j], y2 = x2[j] * rstd * gb[j]; o1[j] = y1 * cs[j] - y2 * sn[j]; o2[j] = y2 * cs[j] + y1 * sn[j]; }
            u32x2 oa, ob; oa.x = cvt_pk_bf16(o1[0], o1[1]); oa.y = cvt_pk_bf16(o1[2], o1[3]); ob.x = cvt_pk_bf16(o2[0], o2[1]); ob.y = cvt_pk_bf16(o2[2], o2[3]);
            *(u32x2*)p = oa; *(u32x2*)(p + 64) = ob; }
    }
}
__device__ __forceinline__ att::BlockRef<att::bf16, att::bf16> att_ref(const bf16_t* QKV, bf16_t* ATT, int item, int pass) {
    const int y = item & 3, r = item >> 2, half = r & 1, i = (r >> 1) & 15, b = r >> 5;
    const int qb = pass ? 7 - y : y;
    att::BlockRef<att::bf16, att::bf16> R; const att::bf16* base = (const att::bf16*)QKV + (size_t)b * SEQ * NP1;
    R.Q = base + (size_t)qb * 256 * NP1 + i * 128; R.K = base + D + i * 128; R.V = base + 2 * D + (i >> 1) * 256 + half * 128;
    R.O = (att::bf16*)ATT + ((size_t)b * SEQ + (size_t)qb * 256) * att::OP + i * 256 + half * 128; R.P0 = qb * 256; return R;
}
__device__ __forceinline__ void attention_phase(Frame& F) {
#if ATT_FORM == 2
    const bf16_t* QKV = (const bf16_t*)(F.ws() + WS_PROJ); bf16_t* ATT = (bf16_t*)(F.ws() + WS_ATT);
    extern __shared__ __attribute__((aligned(16))) char att_lds_[]; char* lds = att_lds_;
    float mref;
    { const CAS Inputs& I = kargs()->in; const int lane = F.lane(); float gq = fmaxf(fabsf(I.diff_q_gain[lane]), fabsf(I.diff_q_gain[64 + lane])), gk = fmaxf(fabsf(I.diff_k_gain[lane]), fabsf(I.diff_k_gain[64 + lane]));
#pragma unroll
      for (int o = 1; o < 64; o <<= 1) { gq = fmaxf(gq, __shfl_xor(gq, o)); gk = fmaxf(gk, __shfl_xor(gk, o)); }
      mref = __builtin_amdgcn_readfirstlane(128.0f * 1.02f * gq * gk); }
    constexpr int NITEM = BATCH * 16 * 8;
    for (int item = F.vcu; item < NITEM; item += F.G) {
        const int y = item & 7, i = (item >> 3) & 15, b = item >> 7;
#pragma unroll 1
        for (int pass = 0; pass < 2; ++pass) {
            const int qb = pass ? 15 - y : y;
            const att::bf16* base = (const att::bf16*)QKV + (size_t)b * SEQ * NP1;
            att2::Block B; B.Q = base + (size_t)qb * 128 * NP1 + i * 128; B.K = base + D + i * 128; B.V = base + 2 * D + (i >> 1) * 256;
            B.O = (att::bf16*)ATT + ((size_t)b * SEQ + (size_t)qb * 128) * att2::OP + i * 256; B.P0 = qb * 128;
            att2::block(B, lds, mref);
        }
    }
#else
    const bf16_t* QKV = (const bf16_t*)(F.ws() + WS_PROJ); bf16_t* ATT = (bf16_t*)(F.ws() + WS_ATT);
    constexpr int NITEM = BATCH * 16 * 2 * 4;
    int item = F.vcu, pass = 0; if (item >= NITEM) return;
    extern __shared__ __attribute__((aligned(16))) char att_lds_[]; char* lds = att_lds_;
    att::BlockRef<att::bf16, att::bf16> cur = att_ref(QKV, ATT, item, 0); att::Seam<att::bf16> S;
    att::causal_swa_prime<att::bf16, att::bf16>(cur, SEQ, lds, S);
    for (;;) {
        int itn = item, pn = pass + 1; bool last = false;
        if (pass == 1) { pn = 0; itn = item + F.G; if (itn >= NITEM) { last = true; itn = item; pn = 1; } }
        const att::BlockRef<att::bf16, att::bf16> nxt = last ? cur : att_ref(QKV, ATT, itn, pn);
        att::causal_swa_block<att::bf16, att::bf16>(cur, nxt, SEQ, SEQ, lds, S);
        if (last) break;
        cur = nxt; item = itn; pass = pn;
    }
#endif
}
__device__ __forceinline__ void mixquant_phase(Frame& F) {
    const int gw = F.vcu * NWAVES + F.wave, NGW = F.G * NWAVES, lane = F.lane();
    const bf16_t* MIX = (const bf16_t*)(F.ws() + WS_MIX); unsigned char* Q = F.ws() + WS_XN; float* QS = (float*)(F.ws() + WS_XNS);
    u32x2 r[8], nx[8];
#define MQ_LOAD(t_, d_) do { _Pragma("unroll") for (int j = 0; j < 8; ++j) d_[j] = __builtin_nontemporal_load((const u32x2*)(MIX + (size_t)(t_) * D) + 64 * j + lane); } while (0)
    if (gw < M) MQ_LOAD(gw, r);
    for (int t = gw; t < M; t += NGW) {
        if (t + NGW < M) MQ_LOAD(t + NGW, nx);
        float amax = 0.f;
#pragma unroll
        for (int j = 0; j < 8; ++j) amax = fmaxf(fmaxf(amax, fmaxf(fabsf(bf_lo(r[j].x)), fabsf(bf_hi(r[j].x)))), fmaxf(fabsf(bf_lo(r[j].y)), fabsf(bf_hi(r[j].y))));
#pragma unroll
        for (int o = 1; o < 64; o <<= 1) amax = fmaxf(amax, __shfl_xor(amax, o));
        const float inv = amax > 0.f ? 127.0f / amax : 0.f;
#pragma unroll
        for (int j = 0; j < 8; ++j) { const int q0 = (int)rintf(bf_lo(r[j].x) * inv), q1 = (int)rintf(bf_hi(r[j].x) * inv), q2 = (int)rintf(bf_lo(r[j].y) * inv), q3 = (int)rintf(bf_hi(r[j].y) * inv);
            *((unsigned*)(Q + (size_t)t * D) + 64 * j + lane) = (unsigned)(q0 & 0xff) | ((unsigned)(q1 & 0xff) << 8) | ((unsigned)(q2 & 0xff) << 16) | ((unsigned)q3 << 24); }
        if (lane == 0) QS[t] = amax * (1.0f / (127.0f * 127.0f));
#pragma unroll
        for (int j = 0; j < 8; ++j) r[j] = nx[j];
    }
#undef MQ_LOAD
}
__device__ __forceinline__ void diffcombine_phase(Frame& F) {
    const CAS Inputs& I = kargs()->in;
    const int gw = F.vcu * NWAVES + F.wave, NGW = F.G * NWAVES, lane = F.lane();
    float lam;
    { const float* lf = I.diff_lambda; const float a0 = lf[lane] * lf[128 + lane] + lf[64 + lane] * lf[128 + 64 + lane], a1 = lf[256 + lane] * lf[384 + lane] + lf[256 + 64 + lane] * lf[384 + 64 + lane];
      lam = expf(wave_sum(a0)) - expf(wave_sum(a1)) + LAMBDA_INIT1; }
    const bf16_t* ATT = (const bf16_t*)(F.ws() + WS_ATT); bf16_t* MIX = (bf16_t*)(F.ws() + WS_MIX);
    const int l32 = lane & 31, hs = lane >> 5;
    const f32x4 g0 = *(const f32x4*)(I.diff_sub_gain + 8 * l32), g1 = *(const f32x4*)(I.diff_sub_gain + 8 * l32 + 4);
    u32x4 ra[4], rb[4], na[4], nb[4];
#define DC_LOAD(t_, a_, b_) do { _Pragma("unroll") for (int it = 0; it < 4; ++it) { const int h = it * 2 + hs; a_[it] = __builtin_nontemporal_load((const u32x4*)(ATT + (size_t)(t_) * 4096 + (2 * h) * 256 + 8 * l32)); b_[it] = __builtin_nontemporal_load((const u32x4*)(ATT + (size_t)(t_) * 4096 + (2 * h + 1) * 256 + 8 * l32)); } } while (0)
    if (gw < M) DC_LOAD(gw, ra, rb);
    for (int t = gw; t < M; t += NGW) {
        float y[4][8]; float amax = 0.f;
        if (t + NGW < M) DC_LOAD(t + NGW, na, nb);
#pragma unroll
        for (int it = 0; it < 4; ++it) { const int h = it * 2 + hs;
            const u32x4 a = ra[it], b = rb[it];
            float o[8] = {bf_lo(a.x) - lam * bf_lo(b.x), bf_hi(a.x) - lam * bf_hi(b.x), bf_lo(a.y) - lam * bf_lo(b.y), bf_hi(a.y) - lam * bf_hi(b.y),
                          bf_lo(a.z) - lam * bf_lo(b.z), bf_hi(a.z) - lam * bf_hi(b.z), bf_lo(a.w) - lam * bf_lo(b.w), bf_hi(a.w) - lam * bf_hi(b.w)};
            float ss = 0.f;
#pragma unroll
            for (int j = 0; j < 8; ++j) ss += o[j] * o[j];
            ss += __shfl_xor(ss, 1); ss += __shfl_xor(ss, 2); ss += __shfl_xor(ss, 4); ss += __shfl_xor(ss, 8); ss += __shfl_xor(ss, 16);
            const float sc = (1.0f - LAMBDA_INIT1) / sqrtf(ss * (1.f / 256.f) + NORM_EPS);
#pragma unroll
            for (int j = 0; j < 8; ++j) { y[it][j] = o[j] * sc * (j < 4 ? g0[j] : g1[j - 4]); amax = fmaxf(amax, fabsf(y[it][j])); } }
#if OUT1_I8
#pragma unroll
        for (int o2 = 1; o2 < 64; o2 <<= 1) amax = fmaxf(amax, __shfl_xor(amax, o2));
        const float inv = amax > 0.f ? 127.0f / amax : 0.f;
#pragma unroll
        for (int it = 0; it < 4; ++it) { const int h = it * 2 + hs; int qv[8];
#pragma unroll
            for (int j = 0; j < 8; ++j) qv[j] = (int)rintf(y[it][j] * inv);
            u32x2 w; w.x = (unsigned)(qv[0] & 0xff) | ((unsigned)(qv[1] & 0xff) << 8) | ((unsigned)(qv[2] & 0xff) << 16) | ((unsigned)qv[3] << 24);
            w.y = (unsigned)(qv[4] & 0xff) | ((unsigned)(qv[5] & 0xff) << 8) | ((unsigned)(qv[6] & 0xff) << 16) | ((unsigned)qv[7] << 24);
            *(u32x2*)((unsigned char*)MIX + (size_t)t * D + h * 256 + 8 * l32) = w; }
        if (lane == 0) ((float*)(F.ws() + WS_XNS))[t] = amax * (1.0f / (127.0f * 127.0f));
#else
#pragma unroll
        for (int it = 0; it < 4; ++it) { const int h = it * 2 + hs;
            u32x4 w; w.x = cvt_pk_bf16(y[it][0], y[it][1]); w.y = cvt_pk_bf16(y[it][2], y[it][3]); w.z = cvt_pk_bf16(y[it][4], y[it][5]); w.w = cvt_pk_bf16(y[it][6], y[it][7]);
            *(u32x4*)(MIX + (size_t)t * D + h * 256 + 8 * l32) = w; }
#endif
#pragma unroll
        for (int it = 0; it < 4; ++it) { ra[it] = na[it]; rb[it] = nb[it]; }
    }
#undef DC_LOAD
}

__global__ void __launch_bounds__(NTHR, 2) trunk_fwd(Args args_unused) {
    extern __shared__ __attribute__((aligned(16))) unsigned char lds[];
#define MK_FRAME() Frame F; F.lds = (LAS unsigned char*)lds; F.wave = __builtin_amdgcn_readfirstlane((int)threadIdx.x >> 6); F.G = gridDim.x; { const int bx = blockIdx.x; F.vcu = (F.G % 8 == 0) ? (bx % 8) * (F.G / 8) + bx / 8 : bx; }
    { MK_FRAME();
      for (int u = F.tid(); u < (LDS_BYTES - LDSCTL_OFF) / 4; u += NTHR) ((LAS unsigned*)(F.lds + LDSCTL_OFF))[u] = 0u;
      __syncthreads();
      if (kargs()->ph_hi - kargs()->ph_lo > 1) (void)xcd_barrier_post(F.ctl() + CW_BAR, (volatile LAS unsigned*)(F.lds + MISC_OFF + 32)); }
#ifndef PH_MASK
#define PH_MASK 0xfff
#endif
#ifndef PH_REPEAT
#define PH_REPEAT 0x0
#endif
#define PH_BEGIN(id) MK_FRAME(); const int lo = kargs()->ph_lo, hi = kargs()->ph_hi; const bool run_ = (STEP_ >= lo && STEP_ < hi) && ((PH_MASK >> (id)) & 1); const int nrep_ = 1 + ((PH_REPEAT >> (id)) & 1)
#define QKF_ (INPROJ_MODE == 2 ? 1 : 0)
#define O0_ (OUT0_I8 ? 1 : 0)
#define STEP_OF(id) (layer == 0 ? ((id) == 1 ? 2 : (id) == 2 ? 3 : (id) == 5 ? 4 : (id) == 6 ? 4 + O0_ : (id) == 7 ? 5 + O0_ : (id) - 9 + 6 + O0_) \
                                : O0_ + ((id) == 1 ? 9 : (id) == 3 ? 10 : (id) <= 6 ? (id) + 7 - QKF_ : (id) == 7 ? 14 - QKF_ : (id) - 9 + 15 - QKF_))
#define PH_END() do { if (run_ && STEP_ + 1 < hi) { XcdBarrier bar; bar.bar = F.ctl() + CW_BAR; bar.x = xb_xcc_id(); bar.st = (volatile LAS unsigned*)(F.lds + MISC_OFF + 32); xcd_barrier(bar); } } while (0)

    { constexpr int STEP_ = 0; PH_BEGIN(0); for (int rep_ = 0; run_ && rep_ < nrep_; ++rep_) p0_prologue(F); PH_END(); }
    { constexpr int STEP_ = 1; PH_BEGIN(0); for (int rep_ = 0; run_ && rep_ < nrep_; ++rep_) convert_weights(F, 0, F.vcu * NWAVES + F.wave, F.G * NWAVES, (LAS unsigned*)(F.lds + F.wave * 16384), 0, P0B_CUT); PH_END(); }

    {
        constexpr int layer = 0;
        { constexpr int STEP_ = STEP_OF(1); PH_BEGIN(1); for (int rep_ = 0; run_ && rep_ < nrep_; ++rep_) {
            unsigned char* ws = F.ws();
            constexpr int ESZ = INPROJ_ESZ;
            pg8::DenseOrder S; S.init(ws + WS_XN, ws + (layer == 0 ? WS_WHIN : WS_WDIN), M, layer == 0 ? NP0 : NP1, D * ESZ, F.G, (int)blockIdx.x);
            if constexpr (layer == 0 || INPROJ_MODE != 2) {
                pg8::EpiAct<INPROJ_MODE == 2> E{(bf16_t*)(ws + WS_PROJ), layer == 0 ? NP0 : NP1, layer == 0 ? 0x9u : 0x0u, 8, (const float*)(ws + WS_XNS), (const float*)(F.ctl() + CW_CMAX + (layer == 0 ? CSC_HIN : CSC_DIN))};
                pg8::gemm_phase<pg8::EpiAct<INPROJ_MODE == 2>, pg8::DenseOrder, INPROJ_MODE>(F.lds, D * ESZ, S, E, 127 - WSH_IN);
            } else {
                const CAS Inputs& I = kargs()->in;
                pg8::EpiQKV E{(bf16_t*)(ws + WS_PROJ), NP1, (const float*)(ws + WS_XNS), (const float*)(F.ctl() + CW_CMAX + CSC_DIN), I.diff_q_gain, I.diff_k_gain, (const float*)(ws + WS_ROPE), (const float*)(ws + WS_ROPE) + (size_t)M * 64, (LAS float*)(F.lds + pg8::STAGE_BYTES)};
                pg8::gemm_phase<pg8::EpiQKV, pg8::DenseOrder, INPROJ_MODE>(F.lds, D * ESZ, S, E, 127 - WSH_IN);
            } }
          PH_END(); }
        if (layer == 0) {
            { constexpr int STEP_ = STEP_OF(2); PH_BEGIN(2); for (int rep_ = 0; run_ && rep_ < nrep_; ++rep_) hgrn_phase(F); PH_END(); }
#if OUT0_I8
            { constexpr int STEP_ = STEP_OF(5); PH_BEGIN(5); for (int rep_ = 0; run_ && rep_ < nrep_; ++rep_) mixquant_phase(F); PH_END(); }
#endif
        } else {
            #if INPROJ_MODE != 2
            { constexpr int STEP_ = STEP_OF(3); PH_BEGIN(3); for (int rep_ = 0; run_ && rep_ < nrep_; ++rep_) qknorm_rope_phase(F); PH_END(); }
#endif
            { constexpr int STEP_ = STEP_OF(4); PH_BEGIN(4); for (int rep_ = 0; run_ && rep_ < nrep_; ++rep_) attention_phase(F); PH_END(); }
            { constexpr int STEP_ = STEP_OF(5); PH_BEGIN(5); for (int rep_ = 0; run_ && rep_ < nrep_; ++rep_) diffcombine_phase(F); PH_END(); }
        }
        { constexpr int STEP_ = STEP_OF(6); PH_BEGIN(6); for (int rep_ = 0; run_ && rep_ < nrep_; ++rep_) {
            unsigned char* ws = F.ws();
            const void* hres_in = layer == 0 ? (const void*)kargs()->in.x : (const void*)(ws + WS_H2);
            constexpr bool I8 = (OUT1_I8 && layer == 1) || (OUT0_I8 && layer == 0); constexpr int ESZ = (FP8_OUTPROJ || I8) ? 1 : 2;
            pg8::DenseOrder S; S.init(ws + ((OUT0_I8 && layer == 0) ? WS_XN : WS_MIX), ws + (layer == 0 ? WS_WHOUT : WS_WDOUT), M, D, D * ESZ, F.G, (int)blockIdx.x);
            pg8::EpiRes<I8, layer == 0> E{(bf16_t*)(ws + WS_H1), hres_in, D, (const float*)(ws + WS_XNS), (const float*)(F.ctl() + CW_CMAX + (layer == 0 ? CSC_HOUT : CSC_DOUT))};
            pg8::gemm_phase<pg8::EpiRes<I8, layer == 0>, pg8::DenseOrder, I8 ? 2 : (FP8_OUTPROJ ? 1 : 0)>(F.lds, D * ESZ, S, E, 127 - WSH_OUT); }
          PH_END(); }
        { constexpr int STEP_ = STEP_OF(7); PH_BEGIN(7); for (int rep_ = 0; run_ && rep_ < nrep_; ++rep_) router_phase(F, (const bf16_t*)(F.ws() + WS_H1), kargs()->in.ffn_norm + (size_t)layer * D, layer); PH_END(); }
        { constexpr int STEP_ = STEP_OF(9); PH_BEGIN(9); for (int rep_ = 0; run_ && rep_ < nrep_; ++rep_) {
            const int nmt = moe_tables(F, layer);
            unsigned char* ws = F.ws();
            constexpr int ESZ = FP8_MOE ? 1 : 2;
            pg8::GatherOrder S; S.init(ws + WS_XF, ws + WS_WGU + (size_t)layer * NE * 1024 * D * ESZ, nmt, 1024, D * ESZ, F.G, (int)blockIdx.x, (const LAS int*)(F.lds + TAB_OFF) + 72); S.list = (const int2*)(ws + WS_LIST); S.est = (const LAS int*)(F.lds + TAB_OFF); S.cntl = S.est + 72 + 192;
            pg8::EpiSwiglu E{(bf16_t*)(ws + WS_HID), S.list, S.est, S.cntl, FF};
            pg8::gemm_phase<pg8::EpiSwiglu, pg8::GatherOrder, FP8_MOE ? 1 : 0>(F.lds, D * ESZ, S, E, 127 - WSH_GU); }
          PH_END(); }
        { constexpr int STEP_ = STEP_OF(10); PH_BEGIN(10); for (int rep_ = 0; run_ && rep_ < nrep_; ++rep_) {
            const int nmt = moe_tables(F, layer);
            unsigned char* ws = F.ws();
            constexpr int ESZ = FP8_MOE ? 1 : 2;
            pg8::GroupOrder S; S.init(ws + WS_HID, ws + WS_WDN + (size_t)layer * NE * D * FF * ESZ, nmt, D, FF * ESZ, F.G, (int)blockIdx.x, (const LAS int*)(F.lds + TAB_OFF) + 72);
            pg8::EpiAct<false, Y_FP8 != 0> E{(bf16_t*)(ws + WS_Y), D, 0x0u, 8, nullptr, nullptr};
            pg8::gemm_phase<pg8::EpiAct<false, Y_FP8 != 0>, pg8::GroupOrder, FP8_MOE ? 1 : 0>(F.lds, FF * ESZ, S, E, 127 - WSH_DN); }
          PH_END(); }
        { constexpr int STEP_ = STEP_OF(11); PH_BEGIN(11); for (int rep_ = 0; run_ && rep_ < nrep_; ++rep_) {
            unsigned char* ws = F.ws();
            if (layer == 0) combine_phase<false>(F, (const bf16_t*)(ws + WS_H1), ws + WS_H2, (bf16_t*)(ws + WS_XN), kargs()->in.mix_norm + D, layer);
            else combine_phase<true>(F, (const bf16_t*)(ws + WS_H1), kargs()->out, nullptr, nullptr, layer); }
          PH_END(); }
        }
    {
        constexpr int layer = 1;
        { constexpr int STEP_ = STEP_OF(1); PH_BEGIN(1); for (int rep_ = 0; run_ && rep_ < nrep_; ++rep_) {
            unsigned char* ws = F.ws();
            constexpr int ESZ = INPROJ_ESZ;
            pg8::DenseOrder S; S.init(ws + WS_XN, ws + (layer == 0 ? WS_WHIN : WS_WDIN), M, layer == 0 ? NP0 : NP1, D * ESZ, F.G, (int)blockIdx.x);
            if constexpr (layer == 0 || INPROJ_MODE != 2) {
                pg8::EpiAct<INPROJ_MODE == 2> E{(bf16_t*)(ws + WS_PROJ), layer == 0 ? NP0 : NP1, layer == 0 ? 0x9u : 0x0u, 8, (const float*)(ws + WS_XNS), (const float*)(F.ctl() + CW_CMAX + (layer == 0 ? CSC_HIN : CSC_DIN))};
                pg8::gemm_phase<pg8::EpiAct<INPROJ_MODE == 2>, pg8::DenseOrder, INPROJ_MODE>(F.lds, D * ESZ, S, E, 127 - WSH_IN);
            } else {
                const CAS Inputs& I = kargs()->in;
                pg8::EpiQKV E{(bf16_t*)(ws + WS_PROJ), NP1, (const float*)(ws + WS_XNS), (const float*)(F.ctl() + CW_CMAX + CSC_DIN), I.diff_q_gain, I.diff_k_gain, (const float*)(ws + WS_ROPE), (const float*)(ws + WS_ROPE) + (size_t)M * 64, (LAS float*)(F.lds + pg8::STAGE_BYTES)};
                pg8::gemm_phase<pg8::EpiQKV, pg8::DenseOrder, INPROJ_MODE>(F.lds, D * ESZ, S, E, 127 - WSH_IN);
            } }
          PH_END(); }
        if (layer == 0) {
            { constexpr int STEP_ = STEP_OF(2); PH_BEGIN(2); for (int rep_ = 0; run_ && rep_ < nrep_; ++rep_) hgrn_phase(F); PH_END(); }
#if OUT0_I8
            { constexpr int STEP_ = STEP_OF(5); PH_BEGIN(5); for (int rep_ = 0; run_ && rep_ < nrep_; ++rep_) mixquant_phase(F); PH_END(); }
#endif
        } else {
            #if INPROJ_MODE != 2
            { constexpr int STEP_ = STEP_OF(3); PH_BEGIN(3); for (int rep_ = 0; run_ && rep_ < nrep_; ++rep_) qknorm_rope_phase(F); PH_END(); }
#endif
            { constexpr int STEP_ = STEP_OF(4); PH_BEGIN(4); for (int rep_ = 0; run_ && rep_ < nrep_; ++rep_) attention_phase(F); PH_END(); }
            { constexpr int STEP_ = STEP_OF(5); PH_BEGIN(5); for (int rep_ = 0; run_ && rep_ < nrep_; ++rep_) diffcombine_phase(F); PH_END(); }
        }
        { constexpr int STEP_ = STEP_OF(6); PH_BEGIN(6); for (int rep_ = 0; run_ && rep_ < nrep_; ++rep_) {
            unsigned char* ws = F.ws();
            const void* hres_in = layer == 0 ? (const void*)kargs()->in.x : (const void*)(ws + WS_H2);
            constexpr bool I8 = (OUT1_I8 && layer == 1) || (OUT0_I8 && layer == 0); constexpr int ESZ = (FP8_OUTPROJ || I8) ? 1 : 2;
            pg8::DenseOrder S; S.init(ws + ((OUT0_I8 && layer == 0) ? WS_XN : WS_MIX), ws + (layer == 0 ? WS_WHOUT : WS_WDOUT), M, D, D * ESZ, F.G, (int)blockIdx.x);
            pg8::EpiRes<I8, layer == 0> E{(bf16_t*)(ws + WS_H1), hres_in, D, (const float*)(ws + WS_XNS), (const float*)(F.ctl() + CW_CMAX + (layer == 0 ? CSC_HOUT : CSC_DOUT))};
            pg8::gemm_phase<pg8::EpiRes<I8, layer == 0>, pg8::DenseOrder, I8 ? 2 : (FP8_OUTPROJ ? 1 : 0)>(F.lds, D * ESZ, S, E, 127 - WSH_OUT); }
          PH_END(); }
        { constexpr int STEP_ = STEP_OF(7); PH_BEGIN(7); for (int rep_ = 0; run_ && rep_ < nrep_; ++rep_) router_phase(F, (const bf16_t*)(F.ws() + WS_H1), kargs()->in.ffn_norm + (size_t)layer * D, layer); PH_END(); }
        { constexpr int STEP_ = STEP_OF(9); PH_BEGIN(9); for (int rep_ = 0; run_ && rep_ < nrep_; ++rep_) {
            const int nmt = moe_tables(F, layer);
            unsigned char* ws = F.ws();
            constexpr int ESZ = FP8_MOE ? 1 : 2;
            pg8::GatherOrder S; S.init(ws + WS_XF, ws + WS_WGU + (size_t)layer * NE * 1024 * D * ESZ, nmt, 1024, D * ESZ, F.G, (int)blockIdx.x, (const LAS int*)(F.lds + TAB_OFF) + 72); S.list = (const int2*)(ws + WS_LIST); S.est = (const LAS int*)(F.lds + TAB_OFF); S.cntl = S.est + 72 + 192;
            pg8::EpiSwiglu E{(bf16_t*)(ws + WS_HID), S.list, S.est, S.cntl, FF};
            pg8::gemm_phase<pg8::EpiSwiglu, pg8::GatherOrder, FP8_MOE ? 1 : 0>(F.lds, D * ESZ, S, E, 127 - WSH_GU); }
          PH_END(); }
        { constexpr int STEP_ = STEP_OF(10); PH_BEGIN(10); for (int rep_ = 0; run_ && rep_ < nrep_; ++rep_) {
            const int nmt = moe_tables(F, layer);
            unsigned char* ws = F.ws();
            constexpr int ESZ = FP8_MOE ? 1 : 2;
            pg8::GroupOrder S; S.init(ws + WS_HID, ws + WS_WDN + (size_t)layer * NE * D * FF * ESZ, nmt, D, FF * ESZ, F.G, (int)blockIdx.x, (const LAS int*)(F.lds + TAB_OFF) + 72);
            pg8::EpiAct<false, Y_FP8 != 0> E{(bf16_t*)(ws + WS_Y), D, 0x0u, 8, nullptr, nullptr};
            pg8::gemm_phase<pg8::EpiAct<false, Y_FP8 != 0>, pg8::GroupOrder, FP8_MOE ? 1 : 0>(F.lds, FF * ESZ, S, E, 127 - WSH_DN); }
          PH_END(); }
        { constexpr int STEP_ = STEP_OF(11); PH_BEGIN(11); for (int rep_ = 0; run_ && rep_ < nrep_; ++rep_) {
            unsigned char* ws = F.ws();
            if (layer == 0) combine_phase<false>(F, (const bf16_t*)(ws + WS_H1), ws + WS_H2, (bf16_t*)(ws + WS_XN), kargs()->in.mix_norm + D, layer);
            else combine_phase<true>(F, (const bf16_t*)(ws + WS_H1), kargs()->out, nullptr, nullptr, layer); }
          PH_END(); }
        }
#undef PH_BEGIN
#undef PH_END
}
constexpr int N_STEPS = 2 + (1 + 1 + 1 + 4) + (1 + 3 + 1 + 4) - (INPROJ_MODE == 2 ? 1 : 0) + (OUT0_I8 ? 1 : 0);

extern "C" void kernel_launch(void* const* d_in, const int* in_sizes, int n_in, void* d_out, int out_size, void* d_ws, size_t ws_size, hipStream_t stream) {
    static int grid = 0;
    if (grid == 0) {
        if (n_in != 19 || in_sizes[0] != M * D || out_size != M * D || ws_size < WS_END) { fprintf(stderr, "kernel_launch: shape/workspace mismatch (n_in %d in0 %d out %d ws %zu need %zu)\n", n_in, n_in > 0 ? in_sizes[0] : -1, out_size, ws_size, (size_t)WS_END); grid = -1; return; }
        int dev = 0, cus = 0, per_cu = 0;
        if (hipGetDevice(&dev) != hipSuccess || hipDeviceGetAttribute(&cus, hipDeviceAttributeMultiprocessorCount, dev) != hipSuccess) { grid = -1; return; }
        if (hipFuncSetAttribute((const void*)trunk_fwd, hipFuncAttributeMaxDynamicSharedMemorySize, LDS_BYTES) != hipSuccess) { fprintf(stderr, "kernel_launch: hipFuncSetAttribute failed\n"); grid = -1; return; }
        if (hipOccupancyMaxActiveBlocksPerMultiprocessor(&per_cu, (const void*)trunk_fwd, NTHR, LDS_BYTES) != hipSuccess || per_cu < 1) fprintf(stderr, "kernel_launch: occupancy query reports %d\n", per_cu);
        (void)hipGetLastError();
        grid = cus;
    }
    if (grid < 0) return;
    if (hipMemsetAsync((char*)d_ws + WS_CTL, 0, CTL_ZERO_BYTES, stream) != hipSuccess) return;
    Args a{};
    const void** ip = (const void**)&a.in;
    for (int i = 0; i < 19; ++i) ip[i] = d_in[i];
    a.out = (float*)d_out; a.ws = (unsigned char*)d_ws;
#if MK_ONE_LAUNCH
    a.ph_lo = 0; a.ph_hi = N_STEPS;
    hipLaunchKernelGGL(trunk_fwd, dim3(grid), dim3(NTHR), LDS_BYTES, stream, a);
#else
    for (int s = 0; s < N_STEPS; ++s) { a.ph_lo = s; a.ph_hi = s + 1;
        for (int rep = 0; rep < 1 + ((PROBE_STEPS >> s) & 1); ++rep) hipLaunchKernelGGL(trunk_fwd, dim3(grid), dim3(NTHR), LDS_BYTES, stream, a); }
#endif
}
```
